# Optimizing an MI355X kernel written in HIP

```python
import jax, jax.numpy as jnp
from jax import lax
import numpy as np

D_MODEL = 1024
BATCH = 8
SEQ = 2048
DEPTH = 1

DILATED_GROUPS = ((128, 1), (512, 4), (2048, 16))
N_ATT_GROUPS = 3
ATT_HEADS_PER_GROUP = 4
ATT_HEAD_DIM = 128
ATT_WIDTH = N_ATT_GROUPS * ATT_HEADS_PER_GROUP * ATT_HEAD_DIM
ATT_OUT_WIDTH = ATT_HEADS_PER_GROUP * ATT_HEAD_DIM
ATT_Q_BLOCK = 128
ROPE_THETA = 500000.0
ROPE_DIMS = ATT_HEAD_DIM // 4
MLSTM_HEADS = 4
MLSTM_WIDTH = D_MODEL
MLSTM_HEAD_DIM = MLSTM_WIDTH // MLSTM_HEADS
MLSTM_CHUNK = 64
CONV_WIDTH = 4
D_FF = ((8 * D_MODEL // 3 + 127) // 128) * 128
RMS_EPS = 1e-6
COL_SIZES = (ATT_WIDTH, ATT_WIDTH, ATT_WIDTH, 2 * MLSTM_WIDTH, MLSTM_WIDTH, MLSTM_WIDTH,
             MLSTM_HEADS, MLSTM_HEADS, D_MODEL, D_MODEL)
IN_WIDTH = 3 * ATT_WIDTH + 4 * MLSTM_WIDTH + 2 * MLSTM_HEADS + 2 * D_MODEL

kernel_name = 'hybrid_dilated_attn_mlstm_macaron_block'


def rmsnorm(x, g):
    xf = x.astype(jnp.float32)
    y = xf * lax.rsqrt(jnp.mean(xf * xf, axis=-1, keepdims=True) + RMS_EPS)
    return (y * g.astype(jnp.float32)).astype(x.dtype)


def swiglu(x, w_gate, w_up, w_down):
    return (jax.nn.silu(x @ w_gate) * (x @ w_up)) @ w_down


def partial_rope(x, positions):
    half = ROPE_DIMS // 2
    inv_freq = jnp.power(ROPE_THETA, -(jnp.arange(half, dtype=jnp.float32) * 2.0 / ROPE_DIMS))
    ang = positions.astype(jnp.float32)[:, None] * inv_freq[None, :]
    cos, sin = jnp.cos(ang)[:, None, :], jnp.sin(ang)[:, None, :]
    xf = x.astype(jnp.float32)
    x1, x2, xp = xf[..., :half], xf[..., half:ROPE_DIMS], xf[..., ROPE_DIMS:]
    out = jnp.concatenate([x1 * cos - x2 * sin, x2 * cos + x1 * sin, xp], axis=-1)
    return out.astype(x.dtype)


def dilated_window_attention(q, k, v, window, dilation):
    B, S, H, dh = q.shape
    L = S // dilation
    span = window // dilation
    bq = ATT_Q_BLOCK
    nblk = -(-L // bq)
    lp = nblk * bq

    def classes(t, front):
        t = t.reshape(B, L, dilation, H, dh)
        return jnp.pad(t, ((0, 0), (front, lp - L), (0, 0), (0, 0), (0, 0)))

    qb = classes(q, 0).reshape(B, nblk, bq, dilation, H, dh)
    idx = np.arange(nblk)[:, None] * bq + np.arange(bq + span)[None, :]
    kw = classes(k, span)[:, idx]
    vw = classes(v, span)[:, idx]
    s = jnp.einsum('bnirhc,bnjrhc->bnrhij', qb, kw).astype(jnp.float32) * (dh ** -0.5)
    qpos = np.arange(nblk)[:, None, None] * bq + np.arange(bq)[None, :, None]
    kpos = np.arange(nblk)[:, None, None] * bq - span + np.arange(bq + span)[None, None, :]
    dist = qpos - kpos
    valid = (dist >= 0) & (dist <= span) & (kpos >= 0)
    s = jnp.where(valid[None, :, None, None], s, -jnp.inf)
    m = jnp.max(s, axis=-1)
    p = jnp.exp(s - m[..., None])
    l = jnp.sum(p, axis=-1)
    o = jnp.einsum('bnrhij,bnjrhc->bnirhc', p, vw.astype(jnp.float32))
    o = o / jnp.moveaxis(l, -1, 2)[..., None]
    lse = jnp.moveaxis(m + jnp.log(l), -1, 2)
    o = o.reshape(B, lp, dilation, H, dh)[:, :L].reshape(B, S, H, dh)
    lse = lse.reshape(B, lp, dilation, H)[:, :L].reshape(B, S, H)
    return o, lse


def causal_depthwise_conv(x, w, b):
    S, K = x.shape[1], w.shape[0]
    xp = jnp.pad(x, ((0, 0), (K - 1, 0), (0, 0)))
    y = b + w[0] * xp[:, 0:S]
    for j in range(1, K):
        y = y + w[j] * xp[:, j:j + S]
    return y


def mlstm_chunkwise(q, k, v, i_pre, log_f):
    B, S, H, dh = q.shape
    lc = MLSTM_CHUNK
    nc = S // lc

    def chunks(t):
        return t.astype(jnp.float32).reshape(B, nc, lc, H, dh).transpose(1, 0, 3, 2, 4)

    def gchunks(t):
        return t.reshape(B, nc, lc, H).transpose(1, 0, 3, 2)

    qc, kc, vc = chunks(q), chunks(k) * (dh ** -0.5), chunks(v)
    ic, fc = gchunks(i_pre), gchunks(log_f)
    causal = np.tril(np.ones((lc, lc), dtype=bool))

    def step(carry, inp):
        C, n, m = carry
        qt, kt, vt, it, ft = inp
        b = jnp.cumsum(ft, axis=-1)
        D = jnp.where(causal, b[..., :, None] - b[..., None, :] + it[..., None, :], -jnp.inf)
        m_inter = b + m[..., None]
        m_t = jnp.maximum(m_inter, jnp.max(D, axis=-1))
        w = jnp.exp(D - m_t[..., None]) * jnp.einsum('bhtk,bhsk->bhts', qt, kt)
        inter = jnp.exp(m_inter - m_t)
        num = jnp.einsum('bhts,bhsv->bhtv', w, vt) + inter[..., None] * jnp.einsum('bhvk,bhtk->bhtv', C, qt)
        den = jnp.sum(w, axis=-1) + inter * jnp.einsum('bhk,bhtk->bht', n, qt)
        h = num / jnp.maximum(jnp.abs(den), jnp.exp(-m_t))[..., None]
        bl = b[..., -1]
        g = bl[..., None] - b + it
        m_new = jnp.maximum(bl + m, jnp.max(g, axis=-1))
        a = jnp.exp(g - m_new[..., None])
        decay = jnp.exp(bl + m - m_new)
        C_new = decay[..., None, None] * C + jnp.einsum('bhsv,bhsk->bhvk', a[..., None] * vt, kt)
        n_new = decay[..., None] * n + jnp.einsum('bhs,bhsk->bhk', a, kt)
        return (C_new, n_new, m_new), h

    init = (jnp.zeros((B, H, dh, dh), jnp.float32), jnp.zeros((B, H, dh), jnp.float32),
            jnp.zeros((B, H), jnp.float32))
    _, hs = lax.scan(step, init, (qc, kc, vc, ic, fc))
    return hs.transpose(1, 0, 3, 2, 4).reshape(B, S, H, dh)


def hybrid_mixer(h, positions, w_in, conv_w, conv_b, i_bias, f_bias, head_g,
                 w_att_branch, w_mlstm_branch, w_out):
    B, S, _ = h.shape
    proj = h @ w_in
    points = np.cumsum(np.array(COL_SIZES))[:-1].tolist()
    q_a, k_a, v_a, qk_m, v_m, o_m, i_pre, f_pre, g_a, g_m = jnp.split(proj, points, axis=-1)

    nh = N_ATT_GROUPS * ATT_HEADS_PER_GROUP
    q_a = partial_rope(q_a.reshape(B, S, nh, ATT_HEAD_DIM), positions)
    k_a = partial_rope(k_a.reshape(B, S, nh, ATT_HEAD_DIM), positions)
    q_a = q_a.reshape(B, S, N_ATT_GROUPS, ATT_HEADS_PER_GROUP, ATT_HEAD_DIM)
    k_a = k_a.reshape(B, S, N_ATT_GROUPS, ATT_HEADS_PER_GROUP, ATT_HEAD_DIM)
    v_a = v_a.reshape(B, S, N_ATT_GROUPS, ATT_HEADS_PER_GROUP, ATT_HEAD_DIM)
    outs, lses = [], []
    for g, (window, dilation) in enumerate(DILATED_GROUPS):
        o, lse = dilated_window_attention(q_a[:, :, g], k_a[:, :, g], v_a[:, :, g], window, dilation)
        outs.append(o)
        lses.append(lse)
    alpha = jax.nn.softmax(jnp.stack(lses, axis=0), axis=0)
    att = jnp.sum(alpha[..., None] * jnp.stack(outs, axis=0), axis=0)
    att = att.reshape(B, S, ATT_OUT_WIDTH).astype(h.dtype)

    qk = jax.nn.silu(causal_depthwise_conv(qk_m, conv_w, conv_b))
    q_m, k_m = jnp.split(qk, 2, axis=-1)
    shp = (B, S, MLSTM_HEADS, MLSTM_HEAD_DIM)
    ig = i_pre.astype(jnp.float32) + i_bias.astype(jnp.float32)
    lf = jax.nn.log_sigmoid(f_pre.astype(jnp.float32) + f_bias.astype(jnp.float32))
    hm = mlstm_chunkwise(q_m.reshape(shp), k_m.reshape(shp), v_m.reshape(shp), ig, lf)
    hm = hm * lax.rsqrt(jnp.mean(hm * hm, axis=-1, keepdims=True) + RMS_EPS)
    hm = hm * head_g.astype(jnp.float32).reshape(MLSTM_HEADS, MLSTM_HEAD_DIM)
    ml = (jax.nn.sigmoid(o_m.astype(jnp.float32)) * hm.reshape(B, S, MLSTM_WIDTH)).astype(h.dtype)

    merged = jax.nn.sigmoid(g_a) * (att @ w_att_branch) + jax.nn.sigmoid(g_m) * (ml @ w_mlstm_branch)
    return merged @ w_out


def setup_inputs(seed: int = 0) -> dict:
    key = jax.random.key(seed)
    ks = jax.random.split(key, 24)
    f32 = jnp.float32

    def dense(k, fan_in, shape):
        return jax.random.normal(k, (DEPTH,) + shape, f32) * (fan_in ** -0.5)

    def gain(k, n):
        return 1.0 + 0.05 * jax.random.normal(k, (DEPTH, n), f32)

    return {
        'x': jax.random.normal(ks[0], (BATCH, SEQ, D_MODEL), f32),
        'ffn1_pre_g': gain(ks[1], D_MODEL),
        'ffn1_w_gate': dense(ks[2], D_MODEL, (D_MODEL, D_FF)),
        'ffn1_w_up': dense(ks[3], D_MODEL, (D_MODEL, D_FF)),
        'ffn1_w_down': dense(ks[4], D_FF, (D_FF, D_MODEL)),
        'ffn1_post_g': gain(ks[5], D_MODEL),
        'mix_pre_g': gain(ks[6], D_MODEL),
        'w_in': dense(ks[7], D_MODEL, (D_MODEL, IN_WIDTH)),
        'conv_w': dense(ks[8], CONV_WIDTH, (CONV_WIDTH, 2 * MLSTM_WIDTH)),
        'conv_b': 0.01 * jax.random.normal(ks[9], (DEPTH, 2 * MLSTM_WIDTH), f32),
        'mlstm_i_bias': 0.1 * jax.random.normal(ks[10], (DEPTH, MLSTM_HEADS), f32),
        'mlstm_f_bias': jnp.linspace(3.0, 6.0, MLSTM_HEADS, dtype=f32)[None, :]
                        + 0.1 * jax.random.normal(ks[11], (DEPTH, MLSTM_HEADS), f32),
        'mlstm_head_g': gain(ks[12], MLSTM_WIDTH),
        'w_att_branch': dense(ks[13], ATT_OUT_WIDTH, (ATT_OUT_WIDTH, D_MODEL)),
        'w_mlstm_branch': dense(ks[14], MLSTM_WIDTH, (MLSTM_WIDTH, D_MODEL)),
        'w_out': dense(ks[15], D_MODEL, (D_MODEL, D_MODEL)),
        'mix_post_g': gain(ks[16], D_MODEL),
        'ffn2_pre_g': gain(ks[17], D_MODEL),
        'ffn2_w_gate': dense(ks[18], D_MODEL, (D_MODEL, D_FF)),
        'ffn2_w_up': dense(ks[19], D_MODEL, (D_MODEL, D_FF)),
        'ffn2_w_down': dense(ks[20], D_FF, (D_FF, D_MODEL)),
        'ffn2_post_g': gain(ks[21], D_MODEL),
    }


def reference(x, ffn1_pre_g, ffn1_w_gate, ffn1_w_up, ffn1_w_down, ffn1_post_g,
              mix_pre_g, w_in, conv_w, conv_b, mlstm_i_bias, mlstm_f_bias, mlstm_head_g,
              w_att_branch, w_mlstm_branch, w_out, mix_post_g,
              ffn2_pre_g, ffn2_w_gate, ffn2_w_up, ffn2_w_down, ffn2_post_g):
    positions = jnp.arange(x.shape[1], dtype=jnp.int32)
    for l in range(DEPTH):
        f = swiglu(rmsnorm(x, ffn1_pre_g[l]), ffn1_w_gate[l], ffn1_w_up[l], ffn1_w_down[l])
        x = x + 0.5 * rmsnorm(f, ffn1_post_g[l])
        y = hybrid_mixer(rmsnorm(x, mix_pre_g[l]), positions, w_in[l], conv_w[l], conv_b[l],
                         mlstm_i_bias[l], mlstm_f_bias[l], mlstm_head_g[l],
                         w_att_branch[l], w_mlstm_branch[l], w_out[l])
        x = x + rmsnorm(y, mix_post_g[l])
        f = swiglu(rmsnorm(x, ffn2_pre_g[l]), ffn2_w_gate[l], ffn2_w_up[l], ffn2_w_down[l])
        x = x + 0.5 * rmsnorm(f, ffn2_post_g[l])
    return x
```

```cpp
#include <hip/hip_runtime.h>
#include <hip/hip_cooperative_groups.h>
#include <cstdio>
#include <cstdint>
namespace cg = cooperative_groups;
namespace pg8 {
#define PG8_LAS __attribute__((address_space(3)))
typedef unsigned short bf16_t;
typedef short bf16x8 __attribute__((ext_vector_type(8)));
typedef float f32x4 __attribute__((ext_vector_type(4)));
typedef unsigned u32x4 __attribute__((ext_vector_type(4)));
constexpr int BM = 256, BK = 64, HALF = 128, HTB = HALF * BK * 2  , STAGE_BYTES = 8 * HTB, NXCD = 8, WGM = 8;

__host__ __device__ __forceinline__ int lds_byte(int r, int c) { const int st = (r >> 4) * 2 + (c >> 5), rr = r & 15, cc = c & 31, ob = rr * 64 + cc * 2; return st * 1024 + (ob ^ (((ob >> 9) & 1) << 5)); }
__host__ __device__ __forceinline__ void stage_rc(int b, int& R, int& C) { const int st = b / 1024, sb = b % 1024, swz = sb ^ (((sb >> 9) & 1) << 5); R = (st >> 1) * 16 + swz / 64; C = (st & 1) * 32 + (swz % 64) / 2; }
__host__ __device__ __forceinline__ int perm32(int rho) { const int n = rho >> 4, i = rho & 15; return 8 * (i >> 2) + 4 * n + (i & 3); }

struct Unit { int pm, pn; };
struct Gemm { const bf16_t* A; const bf16_t* Bt; int M, N, K; };

struct StaticOrder {
    int nM, nN, nwg, G, c;
    __host__ __device__ void init(int M, int N, int G_, int c_) { nM = M / BM; nN = N / BM; nwg = nM * nN; G = G_; c = c_; }
    __host__ __device__ bool next(int i, Unit& u) const {
        const long L = (long)i * G + c; if (L >= nwg) return false;
        int wgid = (int)L; { const int q = nwg / NXCD, r = nwg % NXCD, xcd = wgid % NXCD, off = wgid / NXCD; wgid = (xcd < r ? xcd * (q + 1) : r * (q + 1) + (xcd - r) * q) + off; }
        const int nig = WGM * nN, gid = wgid / nig, fm = gid * WGM, gsz = (nM - fm) < WGM ? (nM - fm) : WGM;
        u.pm = fm + ((wgid % nig) % gsz); u.pn = (wgid % nig) / gsz; return true;
    }
    __device__ __forceinline__ void a_ready(const Unit&) const {}
    __device__ __forceinline__ void done(const Unit&) const {}
};

typedef float f32x2c_t __attribute__((ext_vector_type(2))); typedef __bf16 bf16x2c_t __attribute__((ext_vector_type(2)));
__device__ __forceinline__ unsigned cvt_pk_bf16(float lo, float hi) { const f32x2c_t v = {lo, hi}; const bf16x2c_t b = __builtin_convertvector(v, bf16x2c_t); return __builtin_bit_cast(unsigned, b); }
typedef float f32x2 __attribute__((ext_vector_type(2)));
typedef unsigned u32x2 __attribute__((ext_vector_type(2)));
__device__ __forceinline__ float sigmoidf_(float x) { return 1.0f / (1.0f + __expf(-x)); }
__device__ __forceinline__ void store8(bf16_t* p, const f32x4 v0, const f32x4 v1) {
    u32x4 w; w.x = cvt_pk_bf16(v0[0], v0[1]); w.y = cvt_pk_bf16(v0[2], v0[3]); w.z = cvt_pk_bf16(v1[0], v1[1]); w.w = cvt_pk_bf16(v1[2], v1[3]); *(u32x4*)p = w;
}
__device__ __forceinline__ void load8(const bf16_t* p, f32x4& v0, f32x4& v1) {
    const u32x4 w = *(const u32x4*)p;
    v0[0] = __uint_as_float(w.x << 16); v0[1] = __uint_as_float(w.x & 0xffff0000u); v0[2] = __uint_as_float(w.y << 16); v0[3] = __uint_as_float(w.y & 0xffff0000u);
    v1[0] = __uint_as_float(w.z << 16); v1[1] = __uint_as_float(w.z & 0xffff0000u); v1[2] = __uint_as_float(w.w << 16); v1[3] = __uint_as_float(w.w & 0xffff0000u);
}
template <int MODE> struct Epi {
    static constexpr bool PERM = true, AFTER_DRAIN = false;
    bf16_t* O; int ldc; const bf16_t* G; int ldg; int gcol; const float* rope; float qscale; size_t split_stride;
    __device__ __forceinline__ void operator()(const f32x4 (&acc)[2][2][4][2], const Unit& u, int wr, int wc, int fr, int fq) const {
        const int row0 = u.pm * BM + wr * 64 + fr;
        if constexpr (MODE == 1) {
            const int col0 = u.pn * HALF + wc * 32 + 8 * fq;
#pragma unroll
            for (int ai = 0; ai < 2; ++ai)
#pragma unroll
                for (int m = 0; m < 4; ++m) {
                    f32x4 o[2];
#pragma unroll
                    for (int n = 0; n < 2; ++n)
#pragma unroll
                        for (int i = 0; i < 4; ++i) { const float g = acc[ai][0][m][n][i], up = acc[ai][1][m][n][i]; o[n][i] = g * sigmoidf_(g) * up; }
                    store8(O + (size_t)(row0 + ai * HALF + m * 16) * ldc + col0, o[0], o[1]);
                }
        } else if constexpr (MODE == 3) {
            const int colt = u.pn * BM; const int t = colt / 1536;
            bf16_t* base = O + (size_t)t * split_stride;
            const int lc = colt - t * 1536 + wc * 32 + 8 * fq;
            const bool rp = (t < 2) && (wc == 0);
            const float sc = (t == 0) ? qscale : 1.0f;
            const float sgn = (fq < 2) ? -1.0f : 1.0f;
#pragma unroll
            for (int ai = 0; ai < 2; ++ai)
#pragma unroll
                for (int m = 0; m < 4; ++m) {
                    const int row = row0 + ai * HALF + m * 16;
                    f32x4 cs[2][2];
                    if (rp) {
                        const float* rpt = rope + (size_t)(row & 2047) * 32 + 16 * (fq & 1);
                        cs[0][0] = *(const f32x4*)(rpt); cs[0][1] = *(const f32x4*)(rpt + 4); cs[1][0] = *(const f32x4*)(rpt + 8); cs[1][1] = *(const f32x4*)(rpt + 12);
                    }
#pragma unroll
                    for (int bj = 0; bj < 2; ++bj) {
                        f32x4 o[2];
#pragma unroll
                        for (int n = 0; n < 2; ++n) {
                            f32x4 v = acc[ai][bj][m][n];
                            if (rp) {
                                f32x4 pz;
#pragma unroll
                                for (int i = 0; i < 4; ++i) pz[i] = __shfl_xor(v[i], 32);
                                v[0] = v[0] * cs[n][0][0] + sgn * pz[0] * cs[n][0][1];
                                v[1] = v[1] * cs[n][0][2] + sgn * pz[1] * cs[n][0][3];
                                v[2] = v[2] * cs[n][1][0] + sgn * pz[2] * cs[n][1][1];
                                v[3] = v[3] * cs[n][1][2] + sgn * pz[3] * cs[n][1][3];
                            }
                            o[n] = v * sc;
                        }
                        store8(base + (size_t)row * ldc + lc + bj * HALF, o[0], o[1]);
                    }
                }
        } else {
            const int col0 = u.pn * BM + wc * 32 + 8 * fq;
#pragma unroll
            for (int ai = 0; ai < 2; ++ai)
#pragma unroll
                for (int m = 0; m < 4; ++m) {
                    const int row = row0 + ai * HALF + m * 16;
#pragma unroll
                    for (int bj = 0; bj < 2; ++bj) {
                        f32x4 v0 = acc[ai][bj][m][0], v1 = acc[ai][bj][m][1];
                        bf16_t* op = O + (size_t)row * ldc + col0 + bj * HALF;
                        if constexpr (MODE == 2) {
#pragma unroll
                            for (int i = 0; i < 4; ++i) { v0[i] = sigmoidf_(v0[i]); v1[i] = sigmoidf_(v1[i]); }
                        }
                        if constexpr (MODE == 4 || MODE == 5) {
                            f32x4 g0, g1; load8(G + (size_t)row * ldg + gcol + col0 + bj * HALF, g0, g1);
                            v0 = v0 * g0; v1 = v1 * g1;
                            if constexpr (MODE == 5) { f32x4 t0, t1; load8(op, t0, t1); v0 = v0 + t0; v1 = v1 + t1; }
                        }
                        store8(op, v0, v1);
                    }
                }
        }
    }
};
template <class Epi, class Sched, bool ALIGN_EPI = false, bool SP2 = false>
__device__ __forceinline__ void gemm_phase(PG8_LAS unsigned char* lds, const Gemm g, const Sched& S, const Epi& E) {
    int tid_l = threadIdx.x; asm volatile("" : "+v"(tid_l));
    const int tid = tid_l, wid = __builtin_amdgcn_readfirstlane(tid >> 6), lane = tid & 63, wr = wid >> 2, wc = wid & 3, fr = lane & 15, fq = lane >> 4;
    const int K = g.K, nt = K / BK;
    unsigned voffA[2], voffB[2];
#pragma unroll
    for (int i = 0; i < 2; ++i) { int R, C; stage_rc(tid * 16 + i * 8192, R, C); const int Rb = Epi::PERM ? ((R & ~31) + perm32(R & 31)) : R;
        voffA[i] = (unsigned)(R * K + C) * 2u; voffB[i] = (unsigned)(Rb * K + C) * 2u; }
    const size_t kstep = (size_t)(BK * 2);
    const size_t hstep = (size_t)HALF * K * 2;
    const size_t tstep = 2 * hstep;
    const unsigned ldsw = (unsigned)wid * 1024u;
    const int aoff = lds_byte(wr * 64 + fr, fq * 8), boff = lds_byte(wc * 32 + fr, fq * 8);
#define PG8_SA(b, h) (((b) * 2 + (h)) * HTB)
#define PG8_SB(b, h) ((4 + (b) * 2 + (h)) * HTB)
#define PG8_STAGE(bufoff, gbase, voff) do { _Pragma("unroll") for (int _i = 0; _i < 2; ++_i) \
        __builtin_amdgcn_global_load_lds((const unsigned*)((const char*)(gbase) + (voff)[_i]), (PG8_LAS unsigned*)(lds + (bufoff) + ldsw + _i * 8192), 16, 0, 0); } while (0)
#define PG8_LDA(dst, b, h) do { _Pragma("unroll") for (int m = 0; m < 4; ++m) _Pragma("unroll") for (int k = 0; k < 2; ++k) dst[m][k] = *(const PG8_LAS bf16x8*)(lds + PG8_SA(b, h) + aoff + m * 2048 + k * 1024); } while (0)
#define PG8_LDB(dst, b, h) do { _Pragma("unroll") for (int n = 0; n < 2; ++n) _Pragma("unroll") for (int k = 0; k < 2; ++k) dst[n][k] = *(const PG8_LAS bf16x8*)(lds + PG8_SB(b, h) + boff + n * 2048 + k * 1024); } while (0)
#define PG8_MMA(ai, bj, At, Bt) do { __builtin_amdgcn_s_setprio(1); _Pragma("unroll") for (int m = 0; m < 4; ++m) _Pragma("unroll") for (int n = 0; n < 2; ++n) _Pragma("unroll") for (int k = 0; k < 2; ++k) \
        acc[ai][bj][m][n] = __builtin_amdgcn_mfma_f32_16x16x32_bf16(Bt[n][k], At[m][k], acc[ai][bj][m][n], 0, 0, 0); __builtin_amdgcn_s_setprio(0); } while (0)
#define PG8_WAIT_V(n) asm volatile("s_waitcnt vmcnt(" #n ")" ::: "memory")
#define PG8_WAIT_L(n) asm volatile("s_waitcnt lgkmcnt(" #n ")" ::: "memory")
#define PG8_BAR __builtin_amdgcn_s_barrier()
#define PG8_SCHED __builtin_amdgcn_sched_barrier(0)
    Unit cur, nxt; int ui = 0;
    if (!S.next(0, cur)) return;
    f32x4 acc[2][2][4][2];
#pragma unroll
    for (int a = 0; a < 2; ++a)
#pragma unroll
        for (int b = 0; b < 2; ++b)
#pragma unroll
            for (int m = 0; m < 4; ++m)
#pragma unroll
                for (int n = 0; n < 2; ++n) acc[a][b][m][n] = (f32x4){0.f, 0.f, 0.f, 0.f};
    bf16x8 At[4][2], B0[2][2], B1[2][2];
    const char* cA = (const char*)g.A + (size_t)cur.pm * tstep; const char* cB = (const char*)g.Bt + (size_t)cur.pn * tstep;
    S.a_ready(cur);
    if constexpr (SP2) {
        PG8_STAGE(PG8_SB(0, 0), cB, voffB); PG8_STAGE(PG8_SB(0, 1), cB + hstep, voffB); PG8_STAGE(PG8_SA(0, 0), cA, voffA); PG8_STAGE(PG8_SA(0, 1), cA + hstep, voffA);
        if (wr == 1) PG8_BAR;
        PG8_WAIT_V(2); PG8_BAR;
        PG8_STAGE(PG8_SB(1, 0), cB + kstep, voffB); PG8_STAGE(PG8_SA(1, 0), cA + kstep, voffA); PG8_STAGE(PG8_SB(1, 1), cB + hstep + kstep, voffB);
        PG8_WAIT_V(6); PG8_BAR;
    } else {
        PG8_STAGE(PG8_SB(0, 0), cB, voffB); PG8_STAGE(PG8_SA(0, 0), cA, voffA); PG8_STAGE(PG8_SB(0, 1), cB + hstep, voffB); PG8_STAGE(PG8_SA(0, 1), cA + hstep, voffA);
        if (wr == 1) PG8_BAR;
        PG8_WAIT_V(4); PG8_BAR;
        PG8_STAGE(PG8_SB(1, 0), cB + kstep, voffB); PG8_STAGE(PG8_SA(1, 0), cA + kstep, voffA); PG8_STAGE(PG8_SB(1, 1), cB + hstep + kstep, voffB);
        PG8_WAIT_V(6); PG8_BAR;
    }
    for (;;) {
        const bool has_next = S.next(ui + 1, nxt);
        const char* nA = has_next ? (const char*)g.A + (size_t)nxt.pm * tstep : cA; const char* nB = has_next ? (const char*)g.Bt + (size_t)nxt.pn * tstep : cB;
        for (int t = 0; t < nt; t += 2) {
            const bool last = (t == nt - 2);
            const char* a1 = cA + (size_t)(t + 1) * kstep;
            const char* a2 = last ? nA : cA + (size_t)(t + 2) * kstep; const char* b2 = last ? nB : cB + (size_t)(t + 2) * kstep;
            const char* a3 = a2 + kstep; const char* b3 = b2 + kstep;
            if (last && has_next) S.a_ready(nxt);
            if constexpr (SP2) {
            PG8_LDB(B0, 0, 0); PG8_LDB(B1, 0, 1); PG8_SCHED; PG8_LDA(At, 0, 0); PG8_STAGE(PG8_SA(1, 1), a1 + hstep, voffA);
            PG8_WAIT_V(8); PG8_WAIT_L(0); PG8_BAR; PG8_MMA(0, 0, At, B0); PG8_MMA(0, 1, At, B1); PG8_BAR; PG8_SCHED;
            PG8_LDA(At, 0, 1); PG8_STAGE(PG8_SB(0, 0), b2, voffB); PG8_STAGE(PG8_SB(0, 1), b2 + hstep, voffB); PG8_STAGE(PG8_SA(0, 0), a2, voffA);
            PG8_WAIT_V(8); PG8_WAIT_L(0); PG8_BAR; PG8_MMA(1, 0, At, B0); PG8_MMA(1, 1, At, B1); PG8_BAR; PG8_SCHED;
            PG8_LDB(B0, 1, 0); PG8_LDB(B1, 1, 1); PG8_SCHED; PG8_LDA(At, 1, 0); PG8_STAGE(PG8_SA(0, 1), a2 + hstep, voffA);
            PG8_WAIT_V(8); PG8_WAIT_L(0); PG8_BAR; PG8_MMA(0, 0, At, B0); PG8_MMA(0, 1, At, B1); PG8_BAR; PG8_SCHED;
            PG8_LDA(At, 1, 1); PG8_STAGE(PG8_SB(1, 0), b3, voffB); PG8_STAGE(PG8_SB(1, 1), b3 + hstep, voffB); PG8_STAGE(PG8_SA(1, 0), a3, voffA);
            PG8_WAIT_V(8); PG8_WAIT_L(0); PG8_BAR; PG8_MMA(1, 0, At, B0); PG8_MMA(1, 1, At, B1); PG8_BAR; PG8_SCHED;
            } else {
            PG8_LDB(B0, 0, 0); PG8_SCHED; PG8_LDA(At, 0, 0); PG8_STAGE(PG8_SA(1, 1), a1 + hstep, voffA);
            PG8_WAIT_L(8); PG8_BAR; PG8_WAIT_L(0); PG8_MMA(0, 0, At, B0); PG8_BAR; PG8_SCHED;
            PG8_LDB(B1, 0, 1); PG8_STAGE(PG8_SB(0, 0), b2, voffB);
            PG8_BAR; PG8_WAIT_L(0); PG8_MMA(0, 1, At, B1); PG8_BAR;
            PG8_LDA(At, 0, 1); PG8_STAGE(PG8_SA(0, 0), a2, voffA);
            PG8_BAR; PG8_WAIT_L(0); PG8_MMA(1, 0, At, B0); PG8_BAR; PG8_SCHED;
            PG8_STAGE(PG8_SB(0, 1), b2 + hstep, voffB);
            PG8_WAIT_V(6); PG8_BAR; PG8_MMA(1, 1, At, B1); PG8_BAR;
            PG8_LDB(B0, 1, 0); PG8_SCHED; PG8_LDA(At, 1, 0); PG8_STAGE(PG8_SA(0, 1), a2 + hstep, voffA);
            PG8_WAIT_L(8); PG8_BAR; PG8_WAIT_L(0); PG8_MMA(0, 0, At, B0); PG8_BAR; PG8_SCHED;
            PG8_LDB(B1, 1, 1); PG8_STAGE(PG8_SB(1, 0), b3, voffB);
            PG8_BAR; PG8_WAIT_L(0); PG8_MMA(0, 1, At, B1); PG8_BAR;
            PG8_LDA(At, 1, 1); PG8_STAGE(PG8_SA(1, 0), a3, voffA);
            PG8_BAR; PG8_WAIT_L(0); PG8_MMA(1, 0, At, B0); PG8_BAR; PG8_SCHED;
            PG8_STAGE(PG8_SB(1, 1), b3 + hstep, voffB);
            PG8_WAIT_V(6); PG8_BAR; PG8_MMA(1, 1, At, B1); PG8_BAR;
            }
        }
        if constexpr (ALIGN_EPI) { if (wr == 0) PG8_BAR; }
        if constexpr (!Epi::AFTER_DRAIN) { E(acc, cur, wr, wc, fr, fq); S.done(cur); }
        if (!has_next) break;
#pragma unroll
        for (int a = 0; a < 2; ++a)
#pragma unroll
            for (int b = 0; b < 2; ++b)
#pragma unroll
                for (int m = 0; m < 4; ++m)
#pragma unroll
                    for (int n = 0; n < 2; ++n) acc[a][b][m][n] = (f32x4){0.f, 0.f, 0.f, 0.f};
        cur = nxt; cA = nA; cB = nB; ++ui;
        if constexpr (ALIGN_EPI) { if (wr == 1) PG8_BAR; }
    }
    PG8_WAIT_V(0);
    if constexpr (!ALIGN_EPI) { if (wr == 0) PG8_BAR; }
    PG8_BAR;
    if constexpr (Epi::AFTER_DRAIN) { E.fused(acc, cur, wr, wc, fr, fq, lds, wid, lane); S.done(cur); }
#undef PG8_SA
#undef PG8_SB
#undef PG8_STAGE
#undef PG8_LDA
#undef PG8_LDB
#undef PG8_MMA
#undef PG8_WAIT_V
#undef PG8_WAIT_L
#undef PG8_BAR
#undef PG8_SCHED
}
}

using pg8::bf16_t; using pg8::bf16x8; using pg8::f32x4; using pg8::u32x4; using pg8::u32x2; using pg8::cvt_pk_bf16;
#define LAS __attribute__((address_space(3)))
typedef short s16x4 __attribute__((ext_vector_type(4)));
constexpr int DM = 1024, BATCH = 8, SEQ = 2048, M = BATCH * SEQ, DFF = 2816, INW = 10760;
constexpr float EPS = 1e-6f;
constexpr size_t MiB = 1u << 20;
constexpr size_t WS_IF = 1 * MiB;
constexpr size_t WS_LSE = WS_IF + 512 * 1024;
constexpr size_t WS_ROPE = WS_LSE + 768 * 1024;
constexpr size_t WS_WGU1 = 4 * MiB;
constexpr size_t WS_WD1 = WS_WGU1 + (size_t)5632 * 1024 * 2;
constexpr size_t WS_WGU2 = WS_WD1 + (size_t)1024 * 2816 * 2;
constexpr size_t WS_WD2 = WS_WGU2 + (size_t)5632 * 1024 * 2;
constexpr size_t WS_WIN = WS_WD2 + (size_t)1024 * 2816 * 2;
constexpr size_t WS_WA = WS_WIN + (size_t)10752 * 1024 * 2;
constexpr size_t WS_WM = WS_WA + (size_t)1024 * 512 * 2;
constexpr size_t WS_WO = WS_WM + (size_t)1024 * 1024 * 2;
constexpr size_t WS_WEND = WS_WO + (size_t)1024 * 1024 * 2;
static_assert(WS_WEND <= 63 * MiB, "weights");
constexpr size_t WS_H = 63 * MiB;
constexpr size_t WS_ACT = 95 * MiB;
constexpr size_t WS_F = 183 * MiB;
constexpr size_t WS_Q = 95 * MiB;
constexpr size_t WS_ATT = 239 * MiB;
constexpr size_t WS_QKMV = 143 * MiB;
constexpr size_t WS_HPRE = 95 * MiB;
constexpr size_t WS_OG = 143 * MiB;
constexpr size_t WS_Y = 143 * MiB;
constexpr size_t WS_END = 256 * MiB;
constexpr int LDS_BYTES = 147456, RING_BYTES = 131072;

struct Args {
    const float* in[22]; float* out; unsigned char* ws;
};

__device__ __forceinline__ float wave_sum(float v) {
#pragma unroll
    for (int o = 1; o < 64; o <<= 1) v += __shfl_xor(v, o);
    return v;
}
__device__ __forceinline__ float wave_max(float v) {
#pragma unroll
    for (int o = 1; o < 64; o <<= 1) v = fmaxf(v, __shfl_xor(v, o));
    return v;
}
__device__ __forceinline__ unsigned f2bf(float f) { unsigned u = __float_as_uint(f); return (u + 0x7fffu + ((u >> 16) & 1u)) >> 16; }
__device__ __forceinline__ unsigned pk2(float lo, float hi) { return cvt_pk_bf16(lo, hi); }
__device__ __forceinline__ float bf_lo(unsigned w) { return __uint_as_float(w << 16); }
__device__ __forceinline__ float bf_hi(unsigned w) { return __uint_as_float(w & 0xffff0000u); }
__device__ __forceinline__ s16x4 vtr(const LAS unsigned char* p) { typedef short v4i16_t __attribute__((ext_vector_type(4))); return __builtin_bit_cast(s16x4, __builtin_amdgcn_ds_read_tr16_b64_v4i16((LAS v4i16_t*)p)); }
__device__ __forceinline__ bf16x8 cat8(s16x4 a, s16x4 b) { return (bf16x8){a[0], a[1], a[2], a[3], b[0], b[1], b[2], b[3]}; }
#define MFMA16(a, b, c) __builtin_amdgcn_mfma_f32_16x16x32_bf16((a), (b), (c), 0, 0, 0)

__device__ __forceinline__ void tr_item(const float* W, int ldw, int col0, int k0, bf16_t* WT, int K, int drow0, LAS float* scr, int lane) {
#pragma unroll 8
    for (int i = 0; i < 32; ++i) { const int kk = 2 * i + (lane >> 5); scr[kk * 33 + (lane & 31)] = W[(size_t)(k0 + kk) * ldw + col0 + (lane & 31)]; }
    asm volatile("s_waitcnt lgkmcnt(0)" ::: "memory");
    const int c = lane & 7;
#pragma unroll
    for (int j = 0; j < 4; ++j) { const int n = (lane >> 3) + 8 * j; const LAS float* s = scr + (8 * c) * 33 + n;
        u32x4 o; o.x = pk2(s[0 * 33], s[1 * 33]); o.y = pk2(s[2 * 33], s[3 * 33]); o.z = pk2(s[4 * 33], s[5 * 33]); o.w = pk2(s[6 * 33], s[7 * 33]);
        *(u32x4*)(WT + (size_t)(drow0 + n) * K + k0 + 8 * c) = o; }
    asm volatile("s_waitcnt lgkmcnt(0)" ::: "memory");
}

template <bool HAS_BR, bool WRITE_RES, bool WRITE_NORM, bool DO_IF>
__device__ __forceinline__ void rowpass(int gw, int ngw, int lane, const float* res, const bf16_t* br, float coef, const float* gbr, float* outres,
                                        const float* gn, bf16_t* outn, const LAS f32x4* wif, float* IF) {
    for (int row = gw; row < M; row += ngw) {
        f32x4 v[4];
#pragma unroll
        for (int j = 0; j < 4; ++j) v[j] = *((const f32x4*)(res + (size_t)row * DM) + lane + 64 * j);
        if constexpr (HAS_BR) {
            f32x4 b[4]; float ss = 0.f;
#pragma unroll
            for (int j = 0; j < 4; ++j) { const u32x2 w = *((const u32x2*)(br + (size_t)row * DM) + lane + 64 * j);
                b[j][0] = bf_lo(w.x); b[j][1] = bf_hi(w.x); b[j][2] = bf_lo(w.y); b[j][3] = bf_hi(w.y);
                ss += (b[j][0] * b[j][0] + b[j][1] * b[j][1]) + (b[j][2] * b[j][2] + b[j][3] * b[j][3]); }
            const float rstd = coef * __builtin_amdgcn_rsqf(wave_sum(ss) * (1.0f / DM) + EPS);
#pragma unroll
            for (int j = 0; j < 4; ++j) { const f32x4 g = *((const f32x4*)gbr + lane + 64 * j); v[j] = v[j] + b[j] * g * rstd; }
        }
        if constexpr (WRITE_RES) {
#pragma unroll
            for (int j = 0; j < 4; ++j) *((f32x4*)(outres + (size_t)row * DM) + lane + 64 * j) = v[j];
        }
        if constexpr (WRITE_NORM) {
            float ss = 0.f;
#pragma unroll
            for (int j = 0; j < 4; ++j) ss += (v[j][0] * v[j][0] + v[j][1] * v[j][1]) + (v[j][2] * v[j][2] + v[j][3] * v[j][3]);
            const float rstd = __builtin_amdgcn_rsqf(wave_sum(ss) * (1.0f / DM) + EPS);
            f32x4 hn[4];
#pragma unroll
            for (int j = 0; j < 4; ++j) { const f32x4 g = *((const f32x4*)gn + lane + 64 * j); hn[j] = v[j] * g * rstd;
                u32x2 w; w.x = pk2(hn[j][0], hn[j][1]); w.y = pk2(hn[j][2], hn[j][3]); *((u32x2*)(outn + (size_t)row * DM) + lane + 64 * j) = w; }
            if constexpr (DO_IF) {
                f32x4 a0 = {0.f, 0.f, 0.f, 0.f}, a1 = {0.f, 0.f, 0.f, 0.f};
#pragma unroll
                for (int j = 0; j < 4; ++j)
#pragma unroll
                    for (int e = 0; e < 4; ++e) { const f32x4 w0 = wif[((j * 4 + e) * 2 + 0) * 64 + lane], w1 = wif[((j * 4 + e) * 2 + 1) * 64 + lane];
                        a0 = a0 + w0 * hn[j][e]; a1 = a1 + w1 * hn[j][e]; }
                float r[8];
#pragma unroll
                for (int c = 0; c < 4; ++c) { r[c] = wave_sum(a0[c]); r[4 + c] = wave_sum(a1[c]); }
                if (lane == 0) { *(f32x4*)(IF + (size_t)row * 8) = (f32x4){r[0], r[1], r[2], r[3]}; *(f32x4*)(IF + (size_t)row * 8 + 4) = (f32x4){r[4], r[5], r[6], r[7]}; }
            }
        }
    }
}

__device__ __forceinline__ void attn_item(LAS unsigned char* lds, bf16_t* Qb, const bf16_t* Kb, const bf16_t* Vb, float* LSE, int it, int tid, int wave, int lane) {
    const int g = it >> 9, rem = it & 511, b = rem >> 6, slot = (rem >> 4) & 3, x = rem & 15;
    int dil, r, blk;
    if (g == 0) { dil = 1; r = 0; blk = x; } else if (g == 1) { dil = 4; r = x >> 2; blk = x & 3; } else { dil = 16; r = x; blk = 0; }
    const int q0 = blk * 128, cb = g * 512 + slot * 128;
    const int fr = lane & 15, fq = lane >> 4;
    LAS unsigned char* KS = lds; LAS unsigned char* VS = lds + 65536;
#pragma unroll
    for (int i = 0; i < 8; ++i) {
        const int id = tid + 512 * i, row = id >> 4, ch = id & 15, kn = q0 - 128 + row;
        u32x4 kv = {0u, 0u, 0u, 0u}, vv = {0u, 0u, 0u, 0u};
        if (kn >= 0) { const size_t off = (size_t)(b * SEQ + kn * dil + r) * 1536 + cb + ch * 8; kv = *(const u32x4*)(Kb + off); vv = *(const u32x4*)(Vb + off); }
        *(LAS u32x4*)(KS + row * 256 + ((ch ^ (row & 15)) << 4)) = kv;
        *(LAS u32x4*)(VS + row * 256 + ((ch ^ ((row & 7) << 1)) << 4)) = vv;
    }
    const int qn = q0 + 16 * wave + fr; const size_t qrow = (size_t)(b * SEQ + qn * dil + r);
    bf16x8 qf[4];
#pragma unroll
    for (int ks = 0; ks < 4; ++ks) qf[ks] = *(const bf16x8*)(Qb + qrow * 1536 + cb + 32 * ks + 8 * fq);
    __syncthreads();
    f32x4 sa[9];
#pragma unroll
    for (int j = 0; j < 9; ++j) {
        const int krow = 16 * (wave + j) + fr;
        f32x4 a = {0.f, 0.f, 0.f, 0.f};
#pragma unroll
        for (int ks = 0; ks < 4; ++ks) {
            const bf16x8 kf = *(const LAS bf16x8*)(KS + krow * 256 + (((4 * ks + fq) ^ (krow & 15)) << 4));
            a = MFMA16(kf, qf[ks], a);
        }
        sa[j] = a;
    }
    const int kmin = 128 - q0;
    float mx = -INFINITY;
#pragma unroll
    for (int j = 0; j < 9; ++j)
#pragma unroll
        for (int i = 0; i < 4; ++i) { const int rel = 16 * j + 4 * fq + i - fr, kidx = 16 * (wave + j) + 4 * fq + i;
            const bool ok = (rel >= 0) && (rel <= 128) && (kidx >= kmin);
            sa[j][i] = ok ? sa[j][i] : -INFINITY; mx = fmaxf(mx, sa[j][i]); }
    mx = fmaxf(mx, __shfl_xor(mx, 16)); mx = fmaxf(mx, __shfl_xor(mx, 32));
    float l = 0.f;
#pragma unroll
    for (int j = 0; j < 9; ++j)
#pragma unroll
        for (int i = 0; i < 4; ++i) { const float p = __builtin_amdgcn_exp2f(sa[j][i] - mx); sa[j][i] = p; l += p; }
    l += __shfl_xor(l, 16); l += __shfl_xor(l, 32);
    f32x4 oa[8];
#pragma unroll
    for (int dt = 0; dt < 8; ++dt) oa[dt] = (f32x4){0.f, 0.f, 0.f, 0.f};
    const int tq = fr >> 2, tp = fr & 3;
#pragma unroll
    for (int s2 = 0; s2 < 5; ++s2) {
        u32x4 pw;
        pw.x = pk2(sa[2 * s2][0], sa[2 * s2][1]); pw.y = pk2(sa[2 * s2][2], sa[2 * s2][3]);
        if (s2 < 4) { pw.z = pk2(sa[2 * s2 + 1][0], sa[2 * s2 + 1][1]); pw.w = pk2(sa[2 * s2 + 1][2], sa[2 * s2 + 1][3]); } else { pw.z = 0u; pw.w = 0u; }
        const bf16x8 pf = __builtin_bit_cast(bf16x8, pw);
        int ta = wave + 2 * s2, tb = wave + 2 * s2 + 1; if (tb > 15) tb = 15;
        const int ra = 16 * ta + 4 * fq + tq, rb = 16 * tb + 4 * fq + tq;
#pragma unroll
        for (int dt = 0; dt < 8; ++dt) {
            const int g8 = 4 * dt + tp;
            const s16x4 va = vtr(VS + ra * 256 + ((g8 ^ ((ra & 7) << 2)) << 3));
            const s16x4 vb = vtr(VS + rb * 256 + ((g8 ^ ((rb & 7) << 2)) << 3));
            oa[dt] = MFMA16(cat8(va, vb), pf, oa[dt]);
        }
    }
    const float inv = 1.0f / l;
#pragma unroll
    for (int dt = 0; dt < 8; ++dt) { u32x2 w; w.x = pk2(oa[dt][0] * inv, oa[dt][1] * inv); w.y = pk2(oa[dt][2] * inv, oa[dt][3] * inv);
        *(u32x2*)(Qb + qrow * 1536 + cb + 16 * dt + 4 * fq) = w; }
    if (fq == 0) LSE[qrow * 12 + g * 4 + slot] = (mx + __builtin_amdgcn_logf(l)) * 0.6931471805599453f;
    __syncthreads();
}

constexpr int ML_QS = 0, ML_KS = 33792, ML_CB = 67584, ML_VE = 92928, ML_AV = 99072, ML_WW = 105216, ML_NUM = 114432, ML_SC = 127744;
constexpr int ML_P = 528;
__device__ __forceinline__ float scan_sum(float v, int lane) {
#pragma unroll
    for (int o = 1; o < 64; o <<= 1) { const float t = __shfl_up(v, o); if (lane >= o) v += t; }
    return v;
}
__device__ __forceinline__ float scan_max(float v, int lane) {
#pragma unroll
    for (int o = 1; o < 64; o <<= 1) { const float t = __shfl_up(v, o); if (lane >= o) v = fmaxf(v, t); }
    return v;
}
__device__ __forceinline__ void mlstm_item(LAS unsigned char* lds, const bf16_t* QKMV, const float* IF, const float* conv_w, const float* conv_b, const float* i_bias, const float* f_bias,
                                           bf16_t* HPRE, int it, int tid, int wave, int lane) {
    const int b = it >> 5, h = (it >> 3) & 3, sl = it & 7;
    const int fr = lane & 15, fq = lane >> 4, tq = fr >> 2, tp = fr & 3;
    LAS float* SC = (LAS float*)(lds + ML_SC);
    for (int i = tid; i < 25344 / 4; i += 512) ((LAS unsigned*)(lds + ML_CB))[i] = 0u;
    const int cch = (lane < 32 ? 0 : 1024) + h * 256 + (lane & 31) * 8;
    const int ccol = cch;
    float cw[4][8], cbv[8];
#pragma unroll
    for (int j = 0; j < 4; ++j) { const f32x4 a = *(const f32x4*)(conv_w + j * 2048 + cch), c = *(const f32x4*)(conv_w + j * 2048 + cch + 4);
        cw[j][0] = a[0]; cw[j][1] = a[1]; cw[j][2] = a[2]; cw[j][3] = a[3]; cw[j][4] = c[0]; cw[j][5] = c[1]; cw[j][6] = c[2]; cw[j][7] = c[3]; }
    { const f32x4 a = *(const f32x4*)(conv_b + cch), c = *(const f32x4*)(conv_b + cch + 4);
        cbv[0] = a[0]; cbv[1] = a[1]; cbv[2] = a[2]; cbv[3] = a[3]; cbv[4] = c[0]; cbv[5] = c[1]; cbv[6] = c[2]; cbv[7] = c[3]; }
    const float kscale = (lane < 32) ? 1.0f : 0.0625f;
    const float ib_h = i_bias[h], fb_h = f_bias[h];
    float m_run = 0.f;
    f32x4 cacc[2][3];
#pragma unroll
    for (int a = 0; a < 2; ++a)
#pragma unroll
        for (int v = 0; v < 3; ++v) cacc[a][v] = (f32x4){0.f, 0.f, 0.f, 0.f};
    const size_t rowb = (size_t)b * SEQ;
    for (int c = 0; c < 32; ++c) {
        const int t0 = 64 * c;
        const float ipre = IF[(rowb + t0 + lane) * 8 + h] + ib_h;
        const float fpre = IF[(rowb + t0 + lane) * 8 + 4 + h] + fb_h;
        const float lf = fminf(fpre, 0.f) - log1pf(__expf(-fabsf(fpre)));
        const float bt = scan_sum(lf, lane);
        const float ib = ipre - bt;
        const float cm = scan_max(ib, lane);
        const float mt = bt + fmaxf(m_run, cm);
        const float inter = __expf(bt + m_run - mt);
        const float bl = __shfl(bt, 63);
        const float gs = bl + ib;
        const float m_new = fmaxf(bl + m_run, wave_max(gs));
        const float a_s = __expf(gs - m_new);
        const float decay = __expf(bl + m_run - m_new);
        if (wave == 0) { SC[lane] = ib; SC[64 + lane] = bt - mt; SC[128 + lane] = inter; SC[192 + lane] = __expf(-mt); }
        m_run = m_new;
        {
            const int tg = wave;
            float xr[11][8];
#pragma unroll
            for (int rr = 0; rr < 11; ++rr) {
                const int t = t0 + 8 * tg - 3 + rr;
                u32x4 w = {0u, 0u, 0u, 0u};
                if (t >= 0) w = *(const u32x4*)(QKMV + (rowb + t) * 3072 + ccol);
                xr[rr][0] = bf_lo(w.x); xr[rr][1] = bf_hi(w.x); xr[rr][2] = bf_lo(w.y); xr[rr][3] = bf_hi(w.y);
                xr[rr][4] = bf_lo(w.z); xr[rr][5] = bf_hi(w.z); xr[rr][6] = bf_lo(w.w); xr[rr][7] = bf_hi(w.w);
            }
            LAS unsigned char* dst = lds + (lane < 32 ? ML_QS : ML_KS) + (lane & 31) * 16;
#pragma unroll
            for (int tt = 0; tt < 8; ++tt) {
                float o[8];
#pragma unroll
                for (int e = 0; e < 8; ++e) {
                    float s = cbv[e] + cw[0][e] * xr[tt][e] + cw[1][e] * xr[tt + 1][e] + cw[2][e] * xr[tt + 2][e] + cw[3][e] * xr[tt + 3][e];
                    o[e] = s / (1.0f + __expf(-s)) * kscale;
                }
                u32x4 w; w.x = pk2(o[0], o[1]); w.y = pk2(o[2], o[3]); w.z = pk2(o[4], o[5]); w.w = pk2(o[6], o[7]);
                *(LAS u32x4*)(dst + (8 * tg + tt) * ML_P) = w;
            }
        }
        if (wave < 4) {
            const int t = tid >> 2, c8 = tid & 3;
            const float at = __shfl(a_s, 16 * wave + (lane >> 2));
            const u32x4 w = *(const u32x4*)(QKMV + (rowb + t0 + t) * 3072 + 2048 + h * 256 + sl * 32 + c8 * 8);
            *(LAS u32x4*)(lds + ML_VE + t * 96 + c8 * 16) = w;
            u32x4 o; o.x = pk2(bf_lo(w.x) * at, bf_hi(w.x) * at); o.y = pk2(bf_lo(w.y) * at, bf_hi(w.y) * at); o.z = pk2(bf_lo(w.z) * at, bf_hi(w.z) * at); o.w = pk2(bf_lo(w.w) * at, bf_hi(w.w) * at);
            *(LAS u32x4*)(lds + ML_AV + t * 96 + c8 * 16) = o;
        } else if (wave == 4) {
            const int t = lane;
            *(LAS u32x4*)(lds + ML_VE + t * 96 + 64) = (u32x4){0x3f80u, 0u, 0u, 0u};
            *(LAS u32x4*)(lds + ML_VE + t * 96 + 80) = (u32x4){0u, 0u, 0u, 0u};
            *(LAS u32x4*)(lds + ML_AV + t * 96 + 64) = (u32x4){f2bf(a_s), 0u, 0u, 0u};
            *(LAS u32x4*)(lds + ML_AV + t * 96 + 80) = (u32x4){0u, 0u, 0u, 0u};
        }
        __syncthreads();
        {
            const int tt = wave >> 1;
#pragma unroll
            for (int u = 0; u < 2; ++u) {
                const int st = 2 * (wave & 1) + u;
                f32x4 a = {0.f, 0.f, 0.f, 0.f};
#pragma unroll
                for (int ks = 0; ks < 8; ++ks) {
                    const bf16x8 kf = *(const LAS bf16x8*)(lds + ML_KS + (16 * st + fr) * ML_P + 64 * ks + 16 * fq);
                    const bf16x8 qf = *(const LAS bf16x8*)(lds + ML_QS + (16 * tt + fr) * ML_P + 64 * ks + 16 * fq);
                    a = MFMA16(kf, qf, a);
                }
                const int t = 16 * tt + fr; const float bmt = SC[64 + t];
                float w[4];
#pragma unroll
                for (int i = 0; i < 4; ++i) { const int s = 16 * st + 4 * fq + i; w[i] = (s <= t) ? __expf(bmt + SC[s]) * a[i] : 0.f; }
                u32x2 o; o.x = pk2(w[0], w[1]); o.y = pk2(w[2], w[3]);
                *(LAS u32x2*)(lds + ML_WW + t * 144 + (16 * st + 4 * fq) * 2) = o;
            }
        }
        __syncthreads();
        for (int tile = wave; tile < 12; tile += 8) {
            const int tt = tile & 3, vt = tile >> 2;
            f32x4 aw = {0.f, 0.f, 0.f, 0.f}, ac = {0.f, 0.f, 0.f, 0.f};
#pragma unroll
            for (int k2 = 0; k2 < 2; ++k2) {
                const bf16x8 wf = *(const LAS bf16x8*)(lds + ML_WW + (16 * tt + fr) * 144 + 64 * k2 + 16 * fq);
                const LAS unsigned char* vp = lds + ML_VE + (32 * k2 + 8 * fq + tq) * 96 + (16 * vt + 4 * tp) * 2;
                const s16x4 v0 = vtr(vp), v1 = vtr(vp + 4 * 96);
                aw = MFMA16(wf, cat8(v0, v1), aw);
            }
#pragma unroll
            for (int ks = 0; ks < 8; ++ks) {
                const bf16x8 qf = *(const LAS bf16x8*)(lds + ML_QS + (16 * tt + fr) * ML_P + 64 * ks + 16 * fq);
                const bf16x8 cf = *(const LAS bf16x8*)(lds + ML_CB + (16 * vt + fr) * ML_P + 64 * ks + 16 * fq);
                ac = MFMA16(qf, cf, ac);
            }
#pragma unroll
            for (int i = 0; i < 4; ++i) { const int t = 16 * tt + 4 * fq + i; ((LAS float*)(lds + ML_NUM))[t * 52 + 16 * vt + fr] = aw[i] + SC[128 + t] * ac[i]; }
        }
        __syncthreads();
        {
            const int t = tid >> 3, v4 = (tid & 7) * 4;
            const LAS float* nr = (const LAS float*)(lds + ML_NUM) + t * 52;
            const float den = fmaxf(fabsf(nr[32]), SC[192 + t]); const float inv = 1.0f / den;
            const f32x4 nv = *(const LAS f32x4*)(nr + v4);
            u32x2 o; o.x = pk2(nv[0] * inv, nv[1] * inv); o.y = pk2(nv[2] * inv, nv[3] * inv);
            __hip_atomic_store((unsigned long long*)(HPRE + (rowb + t0 + t) * 1024 + h * 256 + sl * 32 + v4), ((unsigned long long)o.y << 32) | (unsigned long long)o.x, __ATOMIC_RELAXED, __HIP_MEMORY_SCOPE_AGENT);
        }
#if !defined(MLK) || !(MLK & 1)
#pragma unroll
        for (int a = 0; a < 2; ++a) {
            const int kt = 2 * wave + a;
            bf16x8 kf[2];
#pragma unroll
            for (int k2 = 0; k2 < 2; ++k2) {
                const LAS unsigned char* kp = lds + ML_KS + (32 * k2 + 8 * fq + tq) * ML_P + (16 * kt + 4 * tp) * 2;
                kf[k2] = cat8(vtr(kp), vtr(kp + 4 * ML_P));
            }
#pragma unroll
            for (int vt = 0; vt < 3; ++vt) {
                f32x4 acc = cacc[a][vt] * decay;
#pragma unroll
                for (int k2 = 0; k2 < 2; ++k2) {
                    const LAS unsigned char* vp = lds + ML_AV + (32 * k2 + 8 * fq + tq) * 96 + (16 * vt + 4 * tp) * 2;
                    acc = MFMA16(kf[k2], cat8(vtr(vp), vtr(vp + 4 * 96)), acc);
                }
                cacc[a][vt] = acc;
                u32x2 o; o.x = pk2(acc[0], acc[1]); o.y = pk2(acc[2], acc[3]);
                *(LAS u32x2*)(lds + ML_CB + (16 * vt + fr) * ML_P + (16 * kt + 4 * fq) * 2) = o;
            }
        }
#endif
        __syncthreads();
    }
}

#define XB_TMO      128
#define XB_XCNT(j)  (256  + 64 * (j))
#define XB_XSUB(j)  (1280 + 64 * (j))
#define XB_XGEN(j)  (2304 + 64 * (j))
#define XB_TOP      3328
#define XB_TOPGEN   3392
#define XCD_BAR_WORDS 3456
#define XB_SPIN_CAP (1u << 18)

__device__ __forceinline__ unsigned xb_ld(unsigned* p)              { return __hip_atomic_load(p, __ATOMIC_RELAXED, __HIP_MEMORY_SCOPE_AGENT); }
__device__ __forceinline__ unsigned xb_add(unsigned* p, unsigned v) { return __hip_atomic_fetch_add(p, v, __ATOMIC_RELAXED, __HIP_MEMORY_SCOPE_AGENT); }
__device__ __forceinline__ unsigned xb_xcc_id() { return (unsigned)__builtin_amdgcn_s_getreg((3 << 11) | 20) & 0xFu; }
#define XB_SPIN(cond, bar) do { unsigned _sp = 0; while (cond) { __builtin_amdgcn_s_sleep(1); \
    if ((++_sp & 255u) == 0u) { if (xb_ld(&(bar)[XB_TMO])) break; if (_sp > XB_SPIN_CAP) { atomicAdd(&(bar)[XB_TMO], 1u); break; } } } } while (0)

struct XcdBarrier {
    unsigned* bar; unsigned x;
    volatile LAS unsigned* st;
};

__device__ __forceinline__ XcdBarrier xcd_barrier_post(unsigned* bar, volatile LAS unsigned* st) {
    XcdBarrier b; b.bar = bar; b.x = xb_xcc_id(); b.st = st;
    if (threadIdx.x == 0) (void)xb_add(&bar[XB_XCNT(b.x)], 1u);
    return b;
}
__device__ __forceinline__ void xcd_barrier_complete(unsigned* bar, unsigned x, unsigned& nloc, unsigned& nx) {
    const unsigned G = gridDim.x * gridDim.y * gridDim.z;
    unsigned sum, cnt, mine, sp = 0u;
    for (;;) {
        sum = 0u; cnt = 0u; mine = 0u;
#pragma unroll
        for (unsigned j = 0; j < 16; ++j) { const unsigned c = xb_ld(&bar[XB_XCNT(j)]); sum += c; cnt += (c > 0u) ? 1u : 0u; mine = (j == x) ? c : mine; }
        if (sum == G) break;
        __builtin_amdgcn_s_sleep(1);
        if ((++sp & 255u) == 0u) { if (xb_ld(&bar[XB_TMO])) break; if (sp > XB_SPIN_CAP) { atomicAdd(&bar[XB_TMO], 1u); break; } }
    }
    nloc = mine > 0u ? mine : 1u; nx = cnt > 0u ? cnt : 1u;
}

__device__ __forceinline__ void xcd_barrier(const XcdBarrier& b) {
    asm volatile("s_waitcnt vmcnt(0)" ::: "memory");
    __syncthreads();
    if (threadIdx.x == 0) {
        unsigned* bar = b.bar;
        __builtin_amdgcn_s_waitcnt(0);
        unsigned nloc = b.st[0], nx = b.st[1];
        if (nloc == 0u) { xcd_barrier_complete(bar, b.x, nloc, nx); b.st[0] = nloc; b.st[1] = nx; }
        const unsigned old = xb_add(&bar[XB_XSUB(b.x)], 1u);
        const unsigned gen = old / nloc;
        if (old + 1u == (gen + 1u) * nloc) {
            __builtin_amdgcn_fence(__ATOMIC_RELEASE, "agent");
            asm volatile("s_waitcnt vmcnt(0)" ::: "memory");
            const unsigned og = xb_add(&bar[XB_TOP], 1u);
            const unsigned tg = og / nx;
            if (og + 1u == (tg + 1u) * nx) xb_add(&bar[XB_TOPGEN], 1u);
            else XB_SPIN(xb_ld(&bar[XB_TOPGEN]) == tg, bar);
            __builtin_amdgcn_fence(__ATOMIC_ACQUIRE, "agent");
            xb_add(&bar[XB_XGEN(b.x)], 1u);
            asm volatile("s_waitcnt vmcnt(0)" ::: "memory");
        } else {
            XB_SPIN(xb_ld(&bar[XB_XGEN(b.x)]) == gen, bar);
            __builtin_amdgcn_fence(__ATOMIC_ACQUIRE, "agent");
            asm volatile("s_waitcnt vmcnt(0)" ::: "memory");
        }
    }
    __syncthreads();
}

#define grid_seam() xcd_barrier(bar)

__global__ void __launch_bounds__(512, 2) hybrid_fwd(Args args) {
    extern __shared__ __attribute__((aligned(16))) unsigned char lds_raw[];
    LAS unsigned char* lds = (LAS unsigned char*)lds_raw;

    const int tid = threadIdx.x, lane = tid & 63, wave = __builtin_amdgcn_readfirstlane(tid >> 6);
    const int G = gridDim.x, bid = blockIdx.x;
    const int gw = bid * 8 + wave, ngw = G * 8;
    unsigned char* ws = args.ws;
    if (tid < 2) ((LAS unsigned*)(lds + RING_BYTES))[tid] = 0u;
    __syncthreads();
    cg::this_grid().sync();
    XcdBarrier bar = xcd_barrier_post((unsigned*)ws, (volatile LAS unsigned*)(lds + RING_BYTES));
    const float* x = args.in[0];
    float* X = args.out;
    bf16_t* WGU1 = (bf16_t*)(ws + WS_WGU1); bf16_t* WD1 = (bf16_t*)(ws + WS_WD1); bf16_t* WGU2 = (bf16_t*)(ws + WS_WGU2); bf16_t* WD2 = (bf16_t*)(ws + WS_WD2);
    bf16_t* WIN = (bf16_t*)(ws + WS_WIN); bf16_t* WA = (bf16_t*)(ws + WS_WA); bf16_t* WM = (bf16_t*)(ws + WS_WM); bf16_t* WO = (bf16_t*)(ws + WS_WO);
    bf16_t* H = (bf16_t*)(ws + WS_H); bf16_t* ACT = (bf16_t*)(ws + WS_ACT); bf16_t* F = (bf16_t*)(ws + WS_F);
    bf16_t* Qb = (bf16_t*)(ws + WS_Q); bf16_t* ATT = (bf16_t*)(ws + WS_ATT); bf16_t* QKMV = (bf16_t*)(ws + WS_QKMV); bf16_t* HPRE = (bf16_t*)(ws + WS_HPRE);
    bf16_t* OG = (bf16_t*)(ws + WS_OG); bf16_t* Y = (bf16_t*)(ws + WS_Y);
    float* IF = (float*)(ws + WS_IF); float* LSE = (float*)(ws + WS_LSE); float* ROPE = (float*)(ws + WS_ROPE);

    {
        LAS float* scr = (LAS float*)(lds + wave * 16384);
        constexpr int I_G = 16 * 88, I_D = 44 * 32, I_INA = 16 * 272, I_INB = 16 * 64, I_A = 8 * 32, I_M = 16 * 32;
        constexpr int NIT = 6 * I_G + I_INA + I_INB + I_A + 2 * I_M;
        for (int it = gw; it < NIT; it += ngw) {
            int r = it;
            if (r < 4 * I_G) {
                const int w = r / I_G; r -= w * I_G; const int kb = r / 88, nb = r % 88;
                const float* src = args.in[w == 0 ? 2 : w == 1 ? 3 : w == 2 ? 18 : 19];
                tr_item(src, DFF, 32 * nb, 64 * kb, (w < 2) ? WGU1 : WGU2, 1024, 256 * (nb >> 2) + 32 * (nb & 3) + 128 * (w & 1), scr, lane); continue; }
            r -= 4 * I_G;
            if (r < 2 * I_D) {
                const int w = r / I_D; r -= w * I_D; const int kb = r / 32, nb = r % 32;
                tr_item(args.in[w == 0 ? 4 : 20], 1024, 32 * nb, 64 * kb, w == 0 ? WD1 : WD2, DFF, 32 * nb, scr, lane); continue; }
            r -= 2 * I_D;
            if (r < I_INA) { const int kb = r / 272, nb = r % 272; tr_item(args.in[7], INW, 32 * nb, 64 * kb, WIN, 1024, 32 * nb, scr, lane); continue; }
            r -= I_INA;
            if (r < I_INB) { const int kb = r / 64, nb = r % 64; tr_item(args.in[7], INW, 8712 + 32 * nb, 64 * kb, WIN, 1024, 8704 + 32 * nb, scr, lane); continue; }
            r -= I_INB;
            if (r < I_A) { const int kb = r / 32, nb = r % 32; tr_item(args.in[13], 1024, 32 * nb, 64 * kb, WA, 512, 32 * nb, scr, lane); continue; }
            r -= I_A;
            if (r < I_M) { const int kb = r / 32, nb = r % 32; tr_item(args.in[14], 1024, 32 * nb, 64 * kb, WM, 1024, 32 * nb, scr, lane); continue; }
            r -= I_M;
            { const int kb = r / 32, nb = r % 32; tr_item(args.in[15], 1024, 32 * nb, 64 * kb, WO, 1024, 32 * nb, scr, lane); }
        }
        for (int id = bid * 512 + tid; id < 2048 * 16; id += G * 512) {
            const int pos = id >> 4, i = id & 15;
            const float invf = powf(500000.0f, -((float)i * 2.0f / 32.0f));
            const float ang = (float)pos * invf;
            const double a = (double)ang; const double k = rint(a * 0.15915494309189535); const float rr = (float)(a - k * 6.283185307179586);
            ROPE[2 * id] = cosf(rr); ROPE[2 * id + 1] = sinf(rr);
        }
        rowpass<false, false, true, false>(gw, ngw, lane, x, nullptr, 0.f, nullptr, nullptr, args.in[1], H, nullptr, nullptr);
    }
    grid_seam();
    { pg8::Gemm g{H, WGU1, M, 5632, 1024}; pg8::StaticOrder S; S.init(M, 5632, G, bid); pg8::Epi<1> E{ACT, DFF, nullptr, 0, 0, nullptr, 1.f, 0};
      pg8::gemm_phase<pg8::Epi<1>, pg8::StaticOrder, true, true>(lds, g, S, E); }
    grid_seam();
    { pg8::Gemm g{ACT, WD1, M, 1024, DFF}; pg8::StaticOrder S; S.init(M, 1024, G, bid); pg8::Epi<0> E{F, 1024, nullptr, 0, 0, nullptr, 1.f, 0};
      pg8::gemm_phase<pg8::Epi<0>, pg8::StaticOrder, true, true>(lds, g, S, E); }
    grid_seam();
    {
        LAS f32x4* wif = (LAS f32x4*)lds;
        const float* win = args.in[7];
        for (int i = tid; i < 32 * 64; i += 512) { const int ln = i & 63, q = i >> 6, half = q & 1, e = (q >> 1) & 3, j = q >> 3; const int k = 4 * ln + e + 256 * j;
            const float* p = win + (size_t)k * INW + 8704 + 4 * half; wif[i] = (f32x4){p[0], p[1], p[2], p[3]}; }
        __syncthreads();
        rowpass<true, true, true, true>(gw, ngw, lane, x, F, 0.5f, args.in[5], X, args.in[6], H, wif, IF);
        __syncthreads();
    }
    grid_seam();
#if !defined(VAR) || VAR != 1
    { pg8::Gemm g{H, WIN, M, 4608, 1024}; pg8::StaticOrder S; S.init(M, 4608, G, bid);
      pg8::Epi<3> E{Qb, 1536, nullptr, 0, 0, ROPE, 0.08838834764831845f * 1.4426950408889634f, (size_t)M * 1536};
      pg8::gemm_phase<pg8::Epi<3>, pg8::StaticOrder, true, true>(lds, g, S, E); }
    grid_seam();
    for (int it = bid; it < 1536; it += G) attn_item(lds, Qb, Qb + (size_t)M * 1536, Qb + (size_t)2 * M * 1536, LSE, it, tid, wave, lane);
    grid_seam();
    for (int row = gw; row < M; row += ngw) {
        const int slot = lane >> 4;
        const float l0 = LSE[(size_t)row * 12 + slot], l1 = LSE[(size_t)row * 12 + 4 + slot], l2 = LSE[(size_t)row * 12 + 8 + slot];
        const float mx = fmaxf(l0, fmaxf(l1, l2));
        float e0 = __expf(l0 - mx), e1 = __expf(l1 - mx), e2 = __expf(l2 - mx); const float inv = 1.0f / (e0 + e1 + e2); e0 *= inv; e1 *= inv; e2 *= inv;
        f32x4 a0, a1, b0, b1, c0, c1;
        pg8::load8(Qb + (size_t)row * 1536 + 8 * lane, a0, a1); pg8::load8(Qb + (size_t)row * 1536 + 512 + 8 * lane, b0, b1); pg8::load8(Qb + (size_t)row * 1536 + 1024 + 8 * lane, c0, c1);
        pg8::store8(ATT + (size_t)row * 512 + 8 * lane, a0 * e0 + b0 * e1 + c0 * e2, a1 * e0 + b1 * e1 + c1 * e2);
    }
    { pg8::Gemm g{H, WIN + (size_t)4608 * 1024, M, 3072, 1024}; pg8::StaticOrder S; S.init(M, 3072, G, bid); pg8::Epi<0> E{QKMV, 3072, nullptr, 0, 0, nullptr, 1.f, 0};
      pg8::gemm_phase<pg8::Epi<0>, pg8::StaticOrder, true, true>(lds, g, S, E); }
    grid_seam();
#if defined(VAR) && VAR == 4
    for (int row = gw; row < M; row += ngw) { const u32x4 a = *(const u32x4*)(QKMV + (size_t)row * 3072 + 2048 + 16 * lane), b2 = *(const u32x4*)(QKMV + (size_t)row * 3072 + 2048 + 16 * lane + 8);
        *(u32x4*)(HPRE + (size_t)row * 1024 + 16 * lane) = a; *(u32x4*)(HPRE + (size_t)row * 1024 + 16 * lane + 8) = b2; }
#elif !defined(VAR) || VAR != 2
    for (int it = bid; it < 256; it += G) mlstm_item(lds, QKMV, IF, args.in[8], args.in[9], args.in[10], args.in[11], HPRE, it, tid, wave, lane);
#endif
    grid_seam();
    { pg8::Gemm g{H, WIN + (size_t)7680 * 1024, M, 3072, 1024}; pg8::StaticOrder S; S.init(M, 3072, G, bid); pg8::Epi<2> E{OG, 3072, nullptr, 0, 0, nullptr, 1.f, 0};
      pg8::gemm_phase<pg8::Epi<2>, pg8::StaticOrder, true, true>(lds, g, S, E); }
    grid_seam();
#if !defined(VAR) || VAR != 2
    {
        const float* hg = args.in[12];
        for (int row = gw; row < M; row += ngw) {
            bf16_t* hp = HPRE + (size_t)row * 1024 + 16 * lane;
            f32x4 v[4], o[4];
            pg8::load8(hp, v[0], v[1]); pg8::load8(hp + 8, v[2], v[3]);
            pg8::load8(OG + (size_t)row * 3072 + 16 * lane, o[0], o[1]); pg8::load8(OG + (size_t)row * 3072 + 16 * lane + 8, o[2], o[3]);
            float ss = 0.f;
#pragma unroll
            for (int j = 0; j < 4; ++j) ss += (v[j][0] * v[j][0] + v[j][1] * v[j][1]) + (v[j][2] * v[j][2] + v[j][3] * v[j][3]);
            ss += __shfl_xor(ss, 1); ss += __shfl_xor(ss, 2); ss += __shfl_xor(ss, 4); ss += __shfl_xor(ss, 8);
            const float rstd = __builtin_amdgcn_rsqf(ss * (1.0f / 256.0f) + EPS);
#pragma unroll
            for (int j = 0; j < 4; ++j) { const f32x4 gg = *(const f32x4*)(hg + 16 * lane + 4 * j); v[j] = v[j] * gg * o[j] * rstd; }
            pg8::store8(hp, v[0], v[1]); pg8::store8(hp + 8, v[2], v[3]);
        }
    }
#endif
    { pg8::Gemm g{ATT, WA, M, 1024, 512}; pg8::StaticOrder S; S.init(M, 1024, G, bid); pg8::Epi<4> E{H, 1024, OG, 3072, 1024, nullptr, 1.f, 0};
      pg8::gemm_phase<pg8::Epi<4>, pg8::StaticOrder, true, true>(lds, g, S, E); }
    grid_seam();
#if !defined(VAR) || VAR != 2
    { pg8::Gemm g{HPRE, WM, M, 1024, 1024}; pg8::StaticOrder S; S.init(M, 1024, G, bid); pg8::Epi<5> E{H, 1024, OG, 3072, 2048, nullptr, 1.f, 0};
      pg8::gemm_phase<pg8::Epi<5>, pg8::StaticOrder, true, true>(lds, g, S, E); }
#endif
    grid_seam();
    { pg8::Gemm g{H, WO, M, 1024, 1024}; pg8::StaticOrder S; S.init(M, 1024, G, bid); pg8::Epi<0> E{Y, 1024, nullptr, 0, 0, nullptr, 1.f, 0};
      pg8::gemm_phase<pg8::Epi<0>, pg8::StaticOrder, true, true>(lds, g, S, E); }
    grid_seam();
#endif
#if defined(VAR) && VAR == 1
    rowpass<false, false, true, false>(gw, ngw, lane, X, nullptr, 0.f, nullptr, nullptr, args.in[17], H, nullptr, nullptr);
#else
    rowpass<true, true, true, false>(gw, ngw, lane, X, Y, 1.0f, args.in[16], X, args.in[17], H, nullptr, nullptr);
#endif
    grid_seam();
    { pg8::Gemm g{H, WGU2, M, 5632, 1024}; pg8::StaticOrder S; S.init(M, 5632, G, bid); pg8::Epi<1> E{ACT, DFF, nullptr, 0, 0, nullptr, 1.f, 0};
      pg8::gemm_phase<pg8::Epi<1>, pg8::StaticOrder, true, true>(lds, g, S, E); }
    grid_seam();
    { pg8::Gemm g{ACT, WD2, M, 1024, DFF}; pg8::StaticOrder S; S.init(M, 1024, G, bid); pg8::Epi<0> E{F, 1024, nullptr, 0, 0, nullptr, 1.f, 0};
      pg8::gemm_phase<pg8::Epi<0>, pg8::StaticOrder, true, true>(lds, g, S, E); }
    grid_seam();
    rowpass<true, true, false, false>(gw, ngw, lane, X, F, 0.5f, args.in[21], X, nullptr, nullptr, nullptr, nullptr);
}

extern "C" void kernel_launch(void* const* d_in, const int* in_sizes, int n_in, void* d_out, int out_size, void* d_ws, size_t ws_size, hipStream_t stream) {
    static int grid = 0;
    if (grid == 0) {
        if (n_in != 22 || out_size != M * DM || ws_size < WS_END) { fprintf(stderr, "kernel_launch: unexpected shapes (n_in %d out %d ws %zu)\n", n_in, out_size, ws_size); grid = -1; return; }
        int dev = 0, cus = 0, per_cu = 0;
        hipGetDevice(&dev);
        hipDeviceGetAttribute(&cus, hipDeviceAttributeMultiprocessorCount, dev);
        if (hipFuncSetAttribute((const void*)hybrid_fwd, hipFuncAttributeMaxDynamicSharedMemorySize, LDS_BYTES) != hipSuccess) { fprintf(stderr, "kernel_launch: hipFuncSetAttribute failed\n"); grid = -1; return; }
        if (hipOccupancyMaxActiveBlocksPerMultiprocessor(&per_cu, (const void*)hybrid_fwd, 512, LDS_BYTES) != hipSuccess || per_cu < 1) { fprintf(stderr, "kernel_launch: occupancy query says %d\n", per_cu); per_cu = 1; }
        (void)hipGetLastError();
        grid = cus;
        if (grid > 256) grid = 256;
    }
    if (grid < 0) return;
    Args a{};
    for (int i = 0; i < 22; ++i) a.in[i] = (const float*)d_in[i];
    a.out = (float*)d_out; a.ws = (unsigned char*)d_ws;
    if (hipMemsetAsync(d_ws, 0, 16384, stream) != hipSuccess) { fprintf(stderr, "memset failed\n"); return; }
    void* kargs[] = {&a};
    hipError_t e = hipLaunchCooperativeKernel((const void*)hybrid_fwd, dim3(grid), dim3(512), kargs, LDS_BYTES, stream);
    if (e != hipSuccess) fprintf(stderr, "cooperative launch failed: %s (grid %d)\n", hipGetErrorString(e), grid);
}
```

```cpp
#define MLV 1
#include <hip/hip_runtime.h>
#include <hip/hip_cooperative_groups.h>
#include <cstdio>
#include <cstdint>
namespace cg = cooperative_groups;
namespace pg8 {
#define PG8_LAS __attribute__((address_space(3)))
typedef unsigned short bf16_t;
typedef short bf16x8 __attribute__((ext_vector_type(8)));
typedef float f32x4 __attribute__((ext_vector_type(4)));
typedef unsigned u32x4 __attribute__((ext_vector_type(4)));
constexpr int BM = 256, BK = 64, HALF = 128, HTB = HALF * BK * 2  , STAGE_BYTES = 8 * HTB, NXCD = 8, WGM = 8;

__host__ __device__ __forceinline__ int lds_byte(int r, int c) { const int st = (r >> 4) * 2 + (c >> 5), rr = r & 15, cc = c & 31, ob = rr * 64 + cc * 2; return st * 1024 + (ob ^ (((ob >> 9) & 1) << 5)); }
__host__ __device__ __forceinline__ void stage_rc(int b, int& R, int& C) { const int st = b / 1024, sb = b % 1024, swz = sb ^ (((sb >> 9) & 1) << 5); R = (st >> 1) * 16 + swz / 64; C = (st & 1) * 32 + (swz % 64) / 2; }
__host__ __device__ __forceinline__ int perm32(int rho) { const int n = rho >> 4, i = rho & 15; return 8 * (i >> 2) + 4 * n + (i & 3); }

struct Unit { int pm, pn; };
struct Gemm { const bf16_t* A; const bf16_t* Bt; int M, N, K; };

struct StaticOrder {
    int nM, nN, nwg, G, c;
    __host__ __device__ void init(int M, int N, int G_, int c_) { nM = M / BM; nN = N / BM; nwg = nM * nN; G = G_; c = c_; }
    __host__ __device__ bool next(int i, Unit& u) const {
        const long L = (long)i * G + c; if (L >= nwg) return false;
        int wgid = (int)L; { const int q = nwg / NXCD, r = nwg % NXCD, xcd = wgid % NXCD, off = wgid / NXCD; wgid = (xcd < r ? xcd * (q + 1) : r * (q + 1) + (xcd - r) * q) + off; }
        const int nig = WGM * nN, gid = wgid / nig, fm = gid * WGM, gsz = (nM - fm) < WGM ? (nM - fm) : WGM;
        u.pm = fm + ((wgid % nig) % gsz); u.pn = (wgid % nig) / gsz; return true;
    }
    __device__ __forceinline__ void a_ready(const Unit&) const {}
    __device__ __forceinline__ void done(const Unit&) const {}
};

typedef float f32x2c_t __attribute__((ext_vector_type(2))); typedef __bf16 bf16x2c_t __attribute__((ext_vector_type(2)));
__device__ __forceinline__ unsigned cvt_pk_bf16(float lo, float hi) { const f32x2c_t v = {lo, hi}; const bf16x2c_t b = __builtin_convertvector(v, bf16x2c_t); return __builtin_bit_cast(unsigned, b); }
typedef float f32x2 __attribute__((ext_vector_type(2)));
typedef unsigned u32x2 __attribute__((ext_vector_type(2)));
__device__ __forceinline__ float sigmoidf_(float x) { return __builtin_amdgcn_rcpf(1.0f + __expf(-x)); }
__device__ __forceinline__ void store8(bf16_t* p, const f32x4 v0, const f32x4 v1) {
    u32x4 w; w.x = cvt_pk_bf16(v0[0], v0[1]); w.y = cvt_pk_bf16(v0[2], v0[3]); w.z = cvt_pk_bf16(v1[0], v1[1]); w.w = cvt_pk_bf16(v1[2], v1[3]); *(u32x4*)p = w;
}
__device__ __forceinline__ void load8(const bf16_t* p, f32x4& v0, f32x4& v1) {
    const u32x4 w = *(const u32x4*)p;
    v0[0] = __uint_as_float(w.x << 16); v0[1] = __uint_as_float(w.x & 0xffff0000u); v0[2] = __uint_as_float(w.y << 16); v0[3] = __uint_as_float(w.y & 0xffff0000u);
    v1[0] = __uint_as_float(w.z << 16); v1[1] = __uint_as_float(w.z & 0xffff0000u); v1[2] = __uint_as_float(w.w << 16); v1[3] = __uint_as_float(w.w & 0xffff0000u);
}
template <int MODE> struct Epi {
    static constexpr bool PERM = true, AFTER_DRAIN = false;
    bf16_t* O; int ldc; const bf16_t* G; int ldg; int gcol; const float* rope; float qscale; size_t split_stride;
    __device__ __forceinline__ void operator()(const f32x4 (&acc)[2][2][4][2], const Unit& u, int wr, int wc, int fr, int fq) const {
        const int row0 = u.pm * BM + wr * 64 + fr;
        if constexpr (MODE == 1) {
            const int col0 = u.pn * HALF + wc * 32 + 8 * fq;
#pragma unroll
            for (int ai = 0; ai < 2; ++ai)
#pragma unroll
                for (int m = 0; m < 4; ++m) {
                    f32x4 o[2];
#pragma unroll
                    for (int n = 0; n < 2; ++n)
#pragma unroll
                        for (int i = 0; i < 4; ++i) { const float g = acc[ai][0][m][n][i], up = acc[ai][1][m][n][i]; o[n][i] = g * sigmoidf_(g) * up; }
                    store8(O + (size_t)(row0 + ai * HALF + m * 16) * ldc + col0, o[0], o[1]);
                }
        } else if constexpr (MODE == 3) {
            const int colt = u.pn * BM; const int t = colt / 1536;
            bf16_t* base = O + (size_t)t * split_stride;
            const int lc = colt - t * 1536 + wc * 32 + 8 * fq;
            const bool rp = (t < 2) && (wc == 0);
            const float sc = (t == 0) ? qscale : 1.0f;
            const float sgn = (fq < 2) ? -1.0f : 1.0f;
#pragma unroll
            for (int ai = 0; ai < 2; ++ai)
#pragma unroll
                for (int m = 0; m < 4; ++m) {
                    const int row = row0 + ai * HALF + m * 16;
                    f32x4 cs[2][2];
                    if (rp) {
                        const float* rpt = rope + (size_t)(row & 2047) * 32 + 16 * (fq & 1);
                        cs[0][0] = *(const f32x4*)(rpt); cs[0][1] = *(const f32x4*)(rpt + 4); cs[1][0] = *(const f32x4*)(rpt + 8); cs[1][1] = *(const f32x4*)(rpt + 12);
                    }
#pragma unroll
                    for (int bj = 0; bj < 2; ++bj) {
                        f32x4 o[2];
#pragma unroll
                        for (int n = 0; n < 2; ++n) {
                            f32x4 v = acc[ai][bj][m][n];
                            if (rp) {
                                f32x4 pz;
#pragma unroll
                                for (int i = 0; i < 4; ++i) pz[i] = __shfl_xor(v[i], 32);
                                v[0] = v[0] * cs[n][0][0] + sgn * pz[0] * cs[n][0][1];
                                v[1] = v[1] * cs[n][0][2] + sgn * pz[1] * cs[n][0][3];
                                v[2] = v[2] * cs[n][1][0] + sgn * pz[2] * cs[n][1][1];
                                v[3] = v[3] * cs[n][1][2] + sgn * pz[3] * cs[n][1][3];
                            }
                            o[n] = v * sc;
                        }
                        store8(base + (size_t)row * ldc + lc + bj * HALF, o[0], o[1]);
                    }
                }
        } else {
            const int col0 = u.pn * BM + wc * 32 + 8 * fq;
#pragma unroll
            for (int ai = 0; ai < 2; ++ai)
#pragma unroll
                for (int m = 0; m < 4; ++m) {
                    const int row = row0 + ai * HALF + m * 16;
#pragma unroll
                    for (int bj = 0; bj < 2; ++bj) {
                        f32x4 v0 = acc[ai][bj][m][0], v1 = acc[ai][bj][m][1];
                        bf16_t* op = O + (size_t)row * ldc + col0 + bj * HALF;
                        if constexpr (MODE == 2) {
#pragma unroll
                            for (int i = 0; i < 4; ++i) { v0[i] = sigmoidf_(v0[i]); v1[i] = sigmoidf_(v1[i]); }
                        }
                        if constexpr (MODE == 4 || MODE == 5) {
                            f32x4 g0, g1; load8(G + (size_t)row * ldg + gcol + col0 + bj * HALF, g0, g1);
                            v0 = v0 * g0; v1 = v1 * g1;
                            if constexpr (MODE == 5) { f32x4 t0, t1; load8(op, t0, t1); v0 = v0 + t0; v1 = v1 + t1; }
                        }
                        store8(op, v0, v1);
                    }
                }
        }
    }
};
template <class Epi, class Sched, bool ALIGN_EPI = false, bool SP2 = false>
__device__ __forceinline__ void gemm_phase(PG8_LAS unsigned char* lds, const Gemm g, const Sched& S, const Epi& E) {
    int tid_l = threadIdx.x; asm volatile("" : "+v"(tid_l));
    const int tid = tid_l, wid = __builtin_amdgcn_readfirstlane(tid >> 6), lane = tid & 63, wr = wid >> 2, wc = wid & 3, fr = lane & 15, fq = lane >> 4;
    const int K = g.K, nt = K / BK;
    unsigned voffA[2], voffB[2];
#pragma unroll
    for (int i = 0; i < 2; ++i) { int R, C; stage_rc(tid * 16 + i * 8192, R, C); const int Rb = Epi::PERM ? ((R & ~31) + perm32(R & 31)) : R;
        voffA[i] = (unsigned)(R * K + C) * 2u; voffB[i] = (unsigned)(Rb * K + C) * 2u; }
    const size_t kstep = (size_t)(BK * 2);
    const size_t hstep = (size_t)HALF * K * 2;
    const size_t tstep = 2 * hstep;
    const unsigned ldsw = (unsigned)wid * 1024u;
    const int aoff = lds_byte(wr * 64 + fr, fq * 8), boff = lds_byte(wc * 32 + fr, fq * 8);
#define PG8_SA(b, h) (((b) * 2 + (h)) * HTB)
#define PG8_SB(b, h) ((4 + (b) * 2 + (h)) * HTB)
#define PG8_STAGE(bufoff, gbase, voff) do { _Pragma("unroll") for (int _i = 0; _i < 2; ++_i) \
        __builtin_amdgcn_global_load_lds((const unsigned*)((const char*)(gbase) + (voff)[_i]), (PG8_LAS unsigned*)(lds + (bufoff) + ldsw + _i * 8192), 16, 0, 0); } while (0)
#define PG8_LDA(dst, b, h) do { _Pragma("unroll") for (int m = 0; m < 4; ++m) _Pragma("unroll") for (int k = 0; k < 2; ++k) dst[m][k] = *(const PG8_LAS bf16x8*)(lds + PG8_SA(b, h) + aoff + m * 2048 + k * 1024); } while (0)
#define PG8_LDB(dst, b, h) do { _Pragma("unroll") for (int n = 0; n < 2; ++n) _Pragma("unroll") for (int k = 0; k < 2; ++k) dst[n][k] = *(const PG8_LAS bf16x8*)(lds + PG8_SB(b, h) + boff + n * 2048 + k * 1024); } while (0)
#define PG8_MMA(ai, bj, At, Bt) do { __builtin_amdgcn_s_setprio(1); _Pragma("unroll") for (int m = 0; m < 4; ++m) _Pragma("unroll") for (int n = 0; n < 2; ++n) _Pragma("unroll") for (int k = 0; k < 2; ++k) \
        acc[ai][bj][m][n] = __builtin_amdgcn_mfma_f32_16x16x32_bf16(Bt[n][k], At[m][k], acc[ai][bj][m][n], 0, 0, 0); __builtin_amdgcn_s_setprio(0); } while (0)
#define PG8_WAIT_V(n) asm volatile("s_waitcnt vmcnt(" #n ")" ::: "memory")
#define PG8_WAIT_L(n) asm volatile("s_waitcnt lgkmcnt(" #n ")" ::: "memory")
#define PG8_BAR __builtin_amdgcn_s_barrier()
#define PG8_SCHED __builtin_amdgcn_sched_barrier(0)
    Unit cur, nxt; int ui = 0;
    if (!S.next(0, cur)) return;
    f32x4 acc[2][2][4][2];
#pragma unroll
    for (int a = 0; a < 2; ++a)
#pragma unroll
        for (int b = 0; b < 2; ++b)
#pragma unroll
            for (int m = 0; m < 4; ++m)
#pragma unroll
                for (int n = 0; n < 2; ++n) acc[a][b][m][n] = (f32x4){0.f, 0.f, 0.f, 0.f};
    bf16x8 At[4][2], B0[2][2], B1[2][2];
    const char* cA = (const char*)g.A + (size_t)cur.pm * tstep; const char* cB = (const char*)g.Bt + (size_t)cur.pn * tstep;
    S.a_ready(cur);
    if constexpr (SP2) {
        PG8_STAGE(PG8_SB(0, 0), cB, voffB); PG8_STAGE(PG8_SB(0, 1), cB + hstep, voffB); PG8_STAGE(PG8_SA(0, 0), cA, voffA); PG8_STAGE(PG8_SA(0, 1), cA + hstep, voffA);
        if (wr == 1) PG8_BAR;
        PG8_WAIT_V(2); PG8_BAR;
        PG8_STAGE(PG8_SB(1, 0), cB + kstep, voffB); PG8_STAGE(PG8_SA(1, 0), cA + kstep, voffA); PG8_STAGE(PG8_SB(1, 1), cB + hstep + kstep, voffB);
        PG8_WAIT_V(6); PG8_BAR;
    } else {
        PG8_STAGE(PG8_SB(0, 0), cB, voffB); PG8_STAGE(PG8_SA(0, 0), cA, voffA); PG8_STAGE(PG8_SB(0, 1), cB + hstep, voffB); PG8_STAGE(PG8_SA(0, 1), cA + hstep, voffA);
        if (wr == 1) PG8_BAR;
        PG8_WAIT_V(4); PG8_BAR;
        PG8_STAGE(PG8_SB(1, 0), cB + kstep, voffB); PG8_STAGE(PG8_SA(1, 0), cA + kstep, voffA); PG8_STAGE(PG8_SB(1, 1), cB + hstep + kstep, voffB);
        PG8_WAIT_V(6); PG8_BAR;
    }
    for (;;) {
        const bool has_next = S.next(ui + 1, nxt);
        const char* nA = has_next ? (const char*)g.A + (size_t)nxt.pm * tstep : cA; const char* nB = has_next ? (const char*)g.Bt + (size_t)nxt.pn * tstep : cB;
        for (int t = 0; t < nt; t += 2) {
            const bool last = (t == nt - 2);
            const char* a1 = cA + (size_t)(t + 1) * kstep;
            const char* a2 = last ? nA : cA + (size_t)(t + 2) * kstep; const char* b2 = last ? nB : cB + (size_t)(t + 2) * kstep;
            const char* a3 = a2 + kstep; const char* b3 = b2 + kstep;
            if (last && has_next) S.a_ready(nxt);
            if constexpr (SP2) {
            PG8_LDB(B0, 0, 0); PG8_LDB(B1, 0, 1); PG8_SCHED; PG8_LDA(At, 0, 0); PG8_STAGE(PG8_SA(1, 1), a1 + hstep, voffA);
            PG8_WAIT_V(8); PG8_WAIT_L(0); PG8_BAR; PG8_MMA(0, 0, At, B0); PG8_MMA(0, 1, At, B1); PG8_BAR; PG8_SCHED;
            PG8_LDA(At, 0, 1); PG8_STAGE(PG8_SB(0, 0), b2, voffB); PG8_STAGE(PG8_SB(0, 1), b2 + hstep, voffB); PG8_STAGE(PG8_SA(0, 0), a2, voffA);
            PG8_WAIT_V(8); PG8_WAIT_L(0); PG8_BAR; PG8_MMA(1, 0, At, B0); PG8_MMA(1, 1, At, B1); PG8_BAR; PG8_SCHED;
            PG8_LDB(B0, 1, 0); PG8_LDB(B1, 1, 1); PG8_SCHED; PG8_LDA(At, 1, 0); PG8_STAGE(PG8_SA(0, 1), a2 + hstep, voffA);
            PG8_WAIT_V(8); PG8_WAIT_L(0); PG8_BAR; PG8_MMA(0, 0, At, B0); PG8_MMA(0, 1, At, B1); PG8_BAR; PG8_SCHED;
            PG8_LDA(At, 1, 1); PG8_STAGE(PG8_SB(1, 0), b3, voffB); PG8_STAGE(PG8_SB(1, 1), b3 + hstep, voffB); PG8_STAGE(PG8_SA(1, 0), a3, voffA);
            PG8_WAIT_V(8); PG8_WAIT_L(0); PG8_BAR; PG8_MMA(1, 0, At, B0); PG8_MMA(1, 1, At, B1); PG8_BAR; PG8_SCHED;
            } else {
            PG8_LDB(B0, 0, 0); PG8_SCHED; PG8_LDA(At, 0, 0); PG8_STAGE(PG8_SA(1, 1), a1 + hstep, voffA);
            PG8_WAIT_L(8); PG8_BAR; PG8_WAIT_L(0); PG8_MMA(0, 0, At, B0); PG8_BAR; PG8_SCHED;
            PG8_LDB(B1, 0, 1); PG8_STAGE(PG8_SB(0, 0), b2, voffB);
            PG8_BAR; PG8_WAIT_L(0); PG8_MMA(0, 1, At, B1); PG8_BAR;
            PG8_LDA(At, 0, 1); PG8_STAGE(PG8_SA(0, 0), a2, voffA);
            PG8_BAR; PG8_WAIT_L(0); PG8_MMA(1, 0, At, B0); PG8_BAR; PG8_SCHED;
            PG8_STAGE(PG8_SB(0, 1), b2 + hstep, voffB);
            PG8_WAIT_V(6); PG8_BAR; PG8_MMA(1, 1, At, B1); PG8_BAR;
            PG8_LDB(B0, 1, 0); PG8_SCHED; PG8_LDA(At, 1, 0); PG8_STAGE(PG8_SA(0, 1), a2 + hstep, voffA);
            PG8_WAIT_L(8); PG8_BAR; PG8_WAIT_L(0); PG8_MMA(0, 0, At, B0); PG8_BAR; PG8_SCHED;
            PG8_LDB(B1, 1, 1); PG8_STAGE(PG8_SB(1, 0), b3, voffB);
            PG8_BAR; PG8_WAIT_L(0); PG8_MMA(0, 1, At, B1); PG8_BAR;
            PG8_LDA(At, 1, 1); PG8_STAGE(PG8_SA(1, 0), a3, voffA);
            PG8_BAR; PG8_WAIT_L(0); PG8_MMA(1, 0, At, B0); PG8_BAR; PG8_SCHED;
            PG8_STAGE(PG8_SB(1, 1), b3 + hstep, voffB);
            PG8_WAIT_V(6); PG8_BAR; PG8_MMA(1, 1, At, B1); PG8_BAR;
            }
        }
        if constexpr (ALIGN_EPI) { if (wr == 0) PG8_BAR; }
        if constexpr (!Epi::AFTER_DRAIN) { E(acc, cur, wr, wc, fr, fq); S.done(cur); }
        if (!has_next) break;
#pragma unroll
        for (int a = 0; a < 2; ++a)
#pragma unroll
            for (int b = 0; b < 2; ++b)
#pragma unroll
                for (int m = 0; m < 4; ++m)
#pragma unroll
                    for (int n = 0; n < 2; ++n) acc[a][b][m][n] = (f32x4){0.f, 0.f, 0.f, 0.f};
        cur = nxt; cA = nA; cB = nB; ++ui;
        if constexpr (ALIGN_EPI) { if (wr == 1) PG8_BAR; }
    }
    PG8_WAIT_V(0);
    if constexpr (!ALIGN_EPI) { if (wr == 0) PG8_BAR; }
    PG8_BAR;
    if constexpr (Epi::AFTER_DRAIN) { E.fused(acc, cur, wr, wc, fr, fq, lds, wid, lane); S.done(cur); }
#undef PG8_SA
#undef PG8_SB
#undef PG8_STAGE
#undef PG8_LDA
#undef PG8_LDB
#undef PG8_MMA
#undef PG8_WAIT_V
#undef PG8_WAIT_L
#undef PG8_BAR
#undef PG8_SCHED
}
}

using pg8::bf16_t; using pg8::bf16x8; using pg8::f32x4; using pg8::u32x4; using pg8::u32x2; using pg8::cvt_pk_bf16;
#define LAS __attribute__((address_space(3)))
typedef short s16x4 __attribute__((ext_vector_type(4)));
constexpr int DM = 1024, BATCH = 8, SEQ = 2048, M = BATCH * SEQ, DFF = 2816, INW = 10760;
constexpr float EPS = 1e-6f;
constexpr size_t MiB = 1u << 20;
constexpr size_t WS_IF = 1 * MiB;
constexpr size_t WS_LSE = WS_IF + 512 * 1024;
constexpr size_t WS_ROPE = WS_LSE + 768 * 1024;
constexpr size_t WS_GT = WS_ROPE + 256 * 1024;
constexpr size_t WS_WGU1 = 4 * MiB;
constexpr size_t WS_WD1 = WS_WGU1 + (size_t)5632 * 1024 * 2;
constexpr size_t WS_WGU2 = WS_WD1 + (size_t)1024 * 2816 * 2;
constexpr size_t WS_WD2 = WS_WGU2 + (size_t)5632 * 1024 * 2;
constexpr size_t WS_WIN = WS_WD2 + (size_t)1024 * 2816 * 2;
constexpr size_t WS_WA = WS_WIN + (size_t)10752 * 1024 * 2;
constexpr size_t WS_WM = WS_WA + (size_t)1024 * 512 * 2;
constexpr size_t WS_WO = WS_WM + (size_t)1024 * 1024 * 2;
constexpr size_t WS_WEND = WS_WO + (size_t)1024 * 1024 * 2;
static_assert(WS_WEND <= 63 * MiB, "weights");
constexpr size_t WS_H = 63 * MiB;
constexpr size_t WS_ACT = 95 * MiB;
constexpr size_t WS_F = 183 * MiB;
constexpr size_t WS_Q = 95 * MiB;
constexpr size_t WS_ATT = 239 * MiB;
constexpr size_t WS_QKMV = 143 * MiB;
constexpr size_t WS_HPRE = 95 * MiB;
constexpr size_t WS_OG = 143 * MiB;
constexpr size_t WS_Y = 143 * MiB;
constexpr size_t WS_END = 256 * MiB;
constexpr int LDS_BYTES = 147456, RING_BYTES = 131072;

struct Args {
    const float* in[22]; float* out; unsigned char* ws;
};

__device__ __forceinline__ float wave_sum(float v) {
#pragma unroll
    for (int o = 1; o < 64; o <<= 1) v += __shfl_xor(v, o);
    return v;
}
__device__ __forceinline__ float wave_max(float v) {
#pragma unroll
    for (int o = 1; o < 64; o <<= 1) v = fmaxf(v, __shfl_xor(v, o));
    return v;
}
__device__ __forceinline__ unsigned f2bf(float f) { unsigned u = __float_as_uint(f); return (u + 0x7fffu + ((u >> 16) & 1u)) >> 16; }
__device__ __forceinline__ unsigned pk2(float lo, float hi) { return cvt_pk_bf16(lo, hi); }
__device__ __forceinline__ float bf_lo(unsigned w) { return __uint_as_float(w << 16); }
__device__ __forceinline__ float bf_hi(unsigned w) { return __uint_as_float(w & 0xffff0000u); }
__device__ __forceinline__ s16x4 vtr(const LAS unsigned char* p) { typedef short v4i16_t __attribute__((ext_vector_type(4))); return __builtin_bit_cast(s16x4, __builtin_amdgcn_ds_read_tr16_b64_v4i16((LAS v4i16_t*)p)); }
__device__ __forceinline__ bf16x8 cat8(s16x4 a, s16x4 b) { return (bf16x8){a[0], a[1], a[2], a[3], b[0], b[1], b[2], b[3]}; }
#define MFMA16(a, b, c) __builtin_amdgcn_mfma_f32_16x16x32_bf16((a), (b), (c), 0, 0, 0)

__device__ __forceinline__ void tr_item(const float* W, int ldw, int col0, int k0, bf16_t* WT, int K, int drow0, LAS float* scr, int lane) {
#pragma unroll 8
    for (int i = 0; i < 32; ++i) { const int kk = 2 * i + (lane >> 5); scr[kk * 33 + (lane & 31)] = W[(size_t)(k0 + kk) * ldw + col0 + (lane & 31)]; }
    asm volatile("s_waitcnt lgkmcnt(0)" ::: "memory");
    const int c = lane & 7;
#pragma unroll
    for (int j = 0; j < 4; ++j) { const int n = (lane >> 3) + 8 * j; const LAS float* s = scr + (8 * c) * 33 + n;
        u32x4 o; o.x = pk2(s[0 * 33], s[1 * 33]); o.y = pk2(s[2 * 33], s[3 * 33]); o.z = pk2(s[4 * 33], s[5 * 33]); o.w = pk2(s[6 * 33], s[7 * 33]);
        *(u32x4*)(WT + (size_t)(drow0 + n) * K + k0 + 8 * c) = o; }
    asm volatile("s_waitcnt lgkmcnt(0)" ::: "memory");
}

template <bool HAS_BR, bool WRITE_RES, bool WRITE_NORM, bool DO_IF>
__device__ __forceinline__ void rowpass(int gw, int ngw, int lane, const float* res, const bf16_t* br, float coef, const float* gbr, float* outres,
                                        const float* gn, bf16_t* outn, const LAS f32x4* wif, float* IF) {
    for (int row = gw; row < M; row += ngw) {
        f32x4 v[4];
#pragma unroll
        for (int j = 0; j < 4; ++j) v[j] = *((const f32x4*)(res + (size_t)row * DM) + lane + 64 * j);
        if constexpr (HAS_BR) {
            f32x4 b[4]; float ss = 0.f;
#pragma unroll
            for (int j = 0; j < 4; ++j) { const u32x2 w = *((const u32x2*)(br + (size_t)row * DM) + lane + 64 * j);
                b[j][0] = bf_lo(w.x); b[j][1] = bf_hi(w.x); b[j][2] = bf_lo(w.y); b[j][3] = bf_hi(w.y);
                ss += (b[j][0] * b[j][0] + b[j][1] * b[j][1]) + (b[j][2] * b[j][2] + b[j][3] * b[j][3]); }
            const float rstd = coef * __builtin_amdgcn_rsqf(wave_sum(ss) * (1.0f / DM) + EPS);
#pragma unroll
            for (int j = 0; j < 4; ++j) { const f32x4 g = *((const f32x4*)gbr + lane + 64 * j); v[j] = v[j] + b[j] * g * rstd; }
        }
        if constexpr (WRITE_RES) {
#pragma unroll
            for (int j = 0; j < 4; ++j) *((f32x4*)(outres + (size_t)row * DM) + lane + 64 * j) = v[j];
        }
        if constexpr (WRITE_NORM) {
            float ss = 0.f;
#pragma unroll
            for (int j = 0; j < 4; ++j) ss += (v[j][0] * v[j][0] + v[j][1] * v[j][1]) + (v[j][2] * v[j][2] + v[j][3] * v[j][3]);
            const float rstd = __builtin_amdgcn_rsqf(wave_sum(ss) * (1.0f / DM) + EPS);
            f32x4 hn[4];
#pragma unroll
            for (int j = 0; j < 4; ++j) { const f32x4 g = *((const f32x4*)gn + lane + 64 * j); hn[j] = v[j] * g * rstd;
                u32x2 w; w.x = pk2(hn[j][0], hn[j][1]); w.y = pk2(hn[j][2], hn[j][3]); *((u32x2*)(outn + (size_t)row * DM) + lane + 64 * j) = w; }
            if constexpr (DO_IF) {
                f32x4 a0 = {0.f, 0.f, 0.f, 0.f}, a1 = {0.f, 0.f, 0.f, 0.f};
#pragma unroll
                for (int j = 0; j < 4; ++j)
#pragma unroll
                    for (int e = 0; e < 4; ++e) { const f32x4 w0 = wif[((j * 4 + e) * 2 + 0) * 64 + lane], w1 = wif[((j * 4 + e) * 2 + 1) * 64 + lane];
                        a0 = a0 + w0 * hn[j][e]; a1 = a1 + w1 * hn[j][e]; }
                float r[8];
#pragma unroll
                for (int c = 0; c < 4; ++c) { r[c] = wave_sum(a0[c]); r[4 + c] = wave_sum(a1[c]); }
                if (lane == 0) { *(f32x4*)(IF + (size_t)row * 8) = (f32x4){r[0], r[1], r[2], r[3]}; *(f32x4*)(IF + (size_t)row * 8 + 4) = (f32x4){r[4], r[5], r[6], r[7]}; }
            }
        }
    }
}

__device__ __forceinline__ void attn_item(LAS unsigned char* lds, bf16_t* Qb, const bf16_t* Kb, const bf16_t* Vb, float* LSE, int it, int tid, int wave, int lane) {
    const int g = it >> 9, rem = it & 511, b = rem >> 6, slot = (rem >> 4) & 3, x = rem & 15;
    int dil, r, blk;
    if (g == 0) { dil = 1; r = 0; blk = x; } else if (g == 1) { dil = 4; r = x >> 2; blk = x & 3; } else { dil = 16; r = x; blk = 0; }
    const int q0 = blk * 128, cb = g * 512 + slot * 128;
    const int fr = lane & 15, fq = lane >> 4;
    LAS unsigned char* KS = lds; LAS unsigned char* VS = lds + 65536;
#pragma unroll
    for (int i = 0; i < 8; ++i) {
        const int id = tid + 512 * i, row = id >> 4, ch = id & 15, kn = q0 - 128 + row;
        u32x4 kv = {0u, 0u, 0u, 0u}, vv = {0u, 0u, 0u, 0u};
        if (kn >= 0) { const size_t off = (size_t)(b * SEQ + kn * dil + r) * 1536 + cb + ch * 8; kv = *(const u32x4*)(Kb + off); vv = *(const u32x4*)(Vb + off); }
        *(LAS u32x4*)(KS + row * 256 + ((ch ^ (row & 15)) << 4)) = kv;
        *(LAS u32x4*)(VS + row * 256 + ((ch ^ ((row & 7) << 1)) << 4)) = vv;
    }
    const int qn = q0 + 16 * wave + fr; const size_t qrow = (size_t)(b * SEQ + qn * dil + r);
    bf16x8 qf[4];
#pragma unroll
    for (int ks = 0; ks < 4; ++ks) qf[ks] = *(const bf16x8*)(Qb + qrow * 1536 + cb + 32 * ks + 8 * fq);
    __syncthreads();
    f32x4 sa[9];
#pragma unroll
    for (int j = 0; j < 9; ++j) {
        const int krow = 16 * (wave + j) + fr;
        f32x4 a = {0.f, 0.f, 0.f, 0.f};
#pragma unroll
        for (int ks = 0; ks < 4; ++ks) {
            const bf16x8 kf = *(const LAS bf16x8*)(KS + krow * 256 + (((4 * ks + fq) ^ (krow & 15)) << 4));
            a = MFMA16(kf, qf[ks], a);
        }
        sa[j] = a;
    }
    const int kmin = 128 - q0;
    float mx = -INFINITY;
#pragma unroll
    for (int j = 0; j < 9; ++j)
#pragma unroll
        for (int i = 0; i < 4; ++i) { const int rel = 16 * j + 4 * fq + i - fr, kidx = 16 * (wave + j) + 4 * fq + i;
            const bool ok = (rel >= 0) && (rel <= 128) && (kidx >= kmin);
            sa[j][i] = ok ? sa[j][i] : -INFINITY; mx = fmaxf(mx, sa[j][i]); }
    mx = fmaxf(mx, __shfl_xor(mx, 16)); mx = fmaxf(mx, __shfl_xor(mx, 32));
    float l = 0.f;
#pragma unroll
    for (int j = 0; j < 9; ++j)
#pragma unroll
        for (int i = 0; i < 4; ++i) { const float p = __builtin_amdgcn_exp2f(sa[j][i] - mx); sa[j][i] = p; l += p; }
    l += __shfl_xor(l, 16); l += __shfl_xor(l, 32);
    f32x4 oa[8];
#pragma unroll
    for (int dt = 0; dt < 8; ++dt) oa[dt] = (f32x4){0.f, 0.f, 0.f, 0.f};
    const int tq = fr >> 2, tp = fr & 3;
#pragma unroll
    for (int s2 = 0; s2 < 5; ++s2) {
        u32x4 pw;
        pw.x = pk2(sa[2 * s2][0], sa[2 * s2][1]); pw.y = pk2(sa[2 * s2][2], sa[2 * s2][3]);
        if (s2 < 4) { pw.z = pk2(sa[2 * s2 + 1][0], sa[2 * s2 + 1][1]); pw.w = pk2(sa[2 * s2 + 1][2], sa[2 * s2 + 1][3]); } else { pw.z = 0u; pw.w = 0u; }
        const bf16x8 pf = __builtin_bit_cast(bf16x8, pw);
        int ta = wave + 2 * s2, tb = wave + 2 * s2 + 1; if (tb > 15) tb = 15;
        const int ra = 16 * ta + 4 * fq + tq, rb = 16 * tb + 4 * fq + tq;
#pragma unroll
        for (int dt = 0; dt < 8; ++dt) {
            const int g8 = 4 * dt + tp;
            const s16x4 va = vtr(VS + ra * 256 + ((g8 ^ ((ra & 7) << 2)) << 3));
            const s16x4 vb = vtr(VS + rb * 256 + ((g8 ^ ((rb & 7) << 2)) << 3));
            oa[dt] = MFMA16(cat8(va, vb), pf, oa[dt]);
        }
    }
    const float inv = 1.0f / l;
#pragma unroll
    for (int dt = 0; dt < 8; ++dt) { u32x2 w; w.x = pk2(oa[dt][0] * inv, oa[dt][1] * inv); w.y = pk2(oa[dt][2] * inv, oa[dt][3] * inv);
        *(u32x2*)(Qb + qrow * 1536 + cb + 16 * dt + 4 * fq) = w; }
    if (fq == 0) LSE[qrow * 12 + g * 4 + slot] = (mx + __builtin_amdgcn_logf(l)) * 0.6931471805599453f;
    __syncthreads();
}

constexpr int ML_QS = 0, ML_KS = 33792, ML_CB = 67584, ML_VE = 92928, ML_AV = 99072, ML_WW = 105216, ML_NUM = 114432, ML_SC = 127744;
constexpr int ML_P = 528;
__device__ __forceinline__ float scan_sum(float v, int lane) {
#pragma unroll
    for (int o = 1; o < 64; o <<= 1) { const float t = __shfl_up(v, o); if (lane >= o) v += t; }
    return v;
}
__device__ __forceinline__ float scan_max(float v, int lane) {
#pragma unroll
    for (int o = 1; o < 64; o <<= 1) { const float t = __shfl_up(v, o); if (lane >= o) v = fmaxf(v, t); }
    return v;
}
struct ConvHalo { u32x4 h0, h1, h2; };
__device__ __forceinline__ void bf8_to_f(const u32x4 w, float* d) { d[0] = bf_lo(w.x); d[1] = bf_hi(w.x); d[2] = bf_lo(w.y); d[3] = bf_hi(w.y); d[4] = bf_lo(w.z); d[5] = bf_hi(w.z); d[6] = bf_lo(w.w); d[7] = bf_hi(w.w); }
__device__ __forceinline__ void conv_halo(const bf16_t* QKMV, int gid, ConvHalo& H) {
    const int cg = gid & 255, rest = gid >> 8, b = rest >> 6, t0 = (rest & 63) * 32;
    const bf16_t* base = QKMV + (size_t)(b * SEQ) * 3072 + cg * 8;
    H.h0 = (u32x4){0u, 0u, 0u, 0u}; H.h1 = H.h0; H.h2 = H.h0;
    if (t0 > 0) { H.h0 = *(const u32x4*)(base + (size_t)(t0 - 3) * 3072); H.h1 = *(const u32x4*)(base + (size_t)(t0 - 2) * 3072); H.h2 = *(const u32x4*)(base + (size_t)(t0 - 1) * 3072); }
}
__device__ __forceinline__ void conv_run(bf16_t* QKMV, const float* conv_w, const float* conv_b, int gid, const ConvHalo& H) {
    const int cg = gid & 255, rest = gid >> 8, b = rest >> 6, t0 = (rest & 63) * 32;
    bf16_t* base = QKMV + (size_t)(b * SEQ) * 3072 + cg * 8;
    float cw[4][8], cbv[8];
#pragma unroll
    for (int j = 0; j < 4; ++j) { const f32x4 a = *(const f32x4*)(conv_w + j * 2048 + cg * 8), c = *(const f32x4*)(conv_w + j * 2048 + cg * 8 + 4);
        cw[j][0] = a[0]; cw[j][1] = a[1]; cw[j][2] = a[2]; cw[j][3] = a[3]; cw[j][4] = c[0]; cw[j][5] = c[1]; cw[j][6] = c[2]; cw[j][7] = c[3]; }
    { const f32x4 a = *(const f32x4*)(conv_b + cg * 8), c = *(const f32x4*)(conv_b + cg * 8 + 4);
        cbv[0] = a[0]; cbv[1] = a[1]; cbv[2] = a[2]; cbv[3] = a[3]; cbv[4] = c[0]; cbv[5] = c[1]; cbv[6] = c[2]; cbv[7] = c[3]; }
    const float kscale = (cg < 128) ? 1.0f : 0.0625f;
    float x0[8], x1[8], x2[8];
    bf8_to_f(H.h0, x0); bf8_to_f(H.h1, x1); bf8_to_f(H.h2, x2);
    for (int tb = 0; tb < 32; tb += 8) {
        u32x4 raw[8];
#pragma unroll
        for (int r = 0; r < 8; ++r) raw[r] = *(const u32x4*)(base + (size_t)(t0 + tb + r) * 3072);
#pragma unroll
        for (int r = 0; r < 8; ++r) {
            float x3[8], o[8]; bf8_to_f(raw[r], x3);
#pragma unroll
            for (int e = 0; e < 8; ++e) { const float sv = cbv[e] + cw[0][e] * x0[e] + cw[1][e] * x1[e] + cw[2][e] * x2[e] + cw[3][e] * x3[e];
                o[e] = sv * __builtin_amdgcn_rcpf(1.0f + __expf(-sv)) * kscale; x0[e] = x1[e]; x1[e] = x2[e]; x2[e] = x3[e]; }
            u32x4 w; w.x = pk2(o[0], o[1]); w.y = pk2(o[2], o[3]); w.z = pk2(o[4], o[5]); w.w = pk2(o[6], o[7]);
            *(u32x4*)(base + (size_t)(t0 + tb + r) * 3072) = w;
        }
    }
}

__device__ __forceinline__ void gates_prepass(LAS unsigned char* lds, const float* IF, const float* i_bias, const float* f_bias, float* GT, int bh, int tid, int wave, int lane) {
    const int b = bh >> 2, h = bh & 3;
    LAS float* BT = (LAS float*)lds; LAS float* IB = BT + 2048; LAS float* CM = IB + 2048; LAS float* BL = CM + 2048; LAS float* GM = BL + 32; LAS float* MS = GM + 32;
    const float ib_h = i_bias[h], fb_h = f_bias[h];
    for (int c = wave; c < 32; c += 8) {
        const size_t row = (size_t)b * SEQ + 64 * c + lane;
        const float ipre = IF[row * 8 + h] + ib_h, fpre = IF[row * 8 + 4 + h] + fb_h;
        const float lf = fminf(fpre, 0.f) - log1pf(__expf(-fabsf(fpre)));
        const float bt = scan_sum(lf, lane), ib = ipre - bt, cm = scan_max(ib, lane), bl = __shfl(bt, 63), gm = wave_max(bl + ib);
        BT[64 * c + lane] = bt; IB[64 * c + lane] = ib; CM[64 * c + lane] = cm;
        if (lane == 0) { BL[c] = bl; GM[c] = gm; }
    }
    __syncthreads();
    if (tid == 0) { float m = 0.f; MS[0] = 0.f; for (int c = 0; c < 32; ++c) { m = fmaxf(BL[c] + m, GM[c]); MS[c + 1] = m; } }
    __syncthreads();
    for (int c = wave; c < 32; c += 8) {
        const float bt = BT[64 * c + lane], ib = IB[64 * c + lane], cm = CM[64 * c + lane], bl = BL[c], mc = MS[c], mn = MS[c + 1];
        const float mt = bt + fmaxf(mc, cm);
        float* g = GT + ((size_t)bh * 32 + c) * 384;
        g[lane] = ib; g[64 + lane] = bt - mt; g[128 + lane] = __expf(bt + mc - mt); g[192 + lane] = __expf(-mt); g[256 + lane] = __expf(bl + ib - mn); g[320 + lane] = __expf(bl + mc - mn);
    }
    __syncthreads();
}

__device__ __forceinline__ void mlstm_item(LAS unsigned char* lds, const bf16_t* QKMV, const float* GT, bf16_t* HPRE, int it, int tid, int wave, int lane) {
    const int b = it >> 5, h = (it >> 3) & 3, sl = it & 7;
    const int fr = lane & 15, fq = lane >> 4, tq = fr >> 2, tp = fr & 3;
    LAS float* SC = (LAS float*)(lds + ML_SC);
    for (int i = tid; i < 25344 / 4; i += 512) ((LAS unsigned*)(lds + ML_CB))[i] = 0u;
    const int cch = (lane < 32 ? 0 : 1024) + h * 256 + (lane & 31) * 8;
    f32x4 cacc[2][3];
#pragma unroll
    for (int a = 0; a < 2; ++a)
#pragma unroll
        for (int v = 0; v < 3; ++v) cacc[a][v] = (f32x4){0.f, 0.f, 0.f, 0.f};
    const size_t rowb = (size_t)b * SEQ;
    const float* gt = GT + (size_t)(b * 4 + h) * 32 * 384;
    const int tg = wave;
    u32x4 xraw[8]; u32x4 vraw = {0u, 0u, 0u, 0u}; float gpre = 0.f;
#define ML_PREFETCH(c_) do { const int t0_ = 64 * (c_); \
        _Pragma("unroll") for (int rr = 0; rr < 8; ++rr) xraw[rr] = *(const u32x4*)(QKMV + (rowb + t0_ + 8 * tg + rr) * 3072 + cch); \
        if (wave < 4) vraw = *(const u32x4*)(QKMV + (rowb + t0_ + (tid >> 2)) * 3072 + 2048 + h * 256 + sl * 32 + (tid & 3) * 8); \
        if (tid < 384) gpre = gt[(c_) * 384 + tid]; } while (0)
    ML_PREFETCH(0);
    for (int c = 0; c < 32; ++c) {
        const int t0 = 64 * c;
        {
            LAS unsigned char* dst = lds + (lane < 32 ? ML_QS : ML_KS) + (lane & 31) * 16;
#pragma unroll
            for (int tt = 0; tt < 8; ++tt) *(LAS u32x4*)(dst + (8 * tg + tt) * ML_P) = xraw[tt];
        }
        if (wave < 4) { *(LAS u32x4*)(lds + ML_VE + (tid >> 2) * 96 + (tid & 3) * 16) = vraw; }
        else if (wave == 4) { *(LAS u32x4*)(lds + ML_VE + lane * 96 + 64) = (u32x4){0x3f80u, 0u, 0u, 0u}; *(LAS u32x4*)(lds + ML_VE + lane * 96 + 80) = (u32x4){0u, 0u, 0u, 0u}; }
        if (tid < 384) SC[tid] = gpre;
#if !defined(MLV) || !(MLV & 1)
        for (int i = tid; i < 64 * 52; i += 512) ((LAS float*)(lds + ML_NUM))[i] = 0.f;
#endif
        if (c + 1 < 32) ML_PREFETCH(c + 1);
        __syncthreads();
        if (wave < 4) {
            const int t = tid >> 2, c8 = tid & 3; const float at = SC[256 + t];
            const u32x4 w = *(const LAS u32x4*)(lds + ML_VE + t * 96 + c8 * 16);
            u32x4 o; o.x = pk2(bf_lo(w.x) * at, bf_hi(w.x) * at); o.y = pk2(bf_lo(w.y) * at, bf_hi(w.y) * at); o.z = pk2(bf_lo(w.z) * at, bf_hi(w.z) * at); o.w = pk2(bf_lo(w.w) * at, bf_hi(w.w) * at);
            *(LAS u32x4*)(lds + ML_AV + t * 96 + c8 * 16) = o;
        } else if (wave == 4) {
            *(LAS u32x4*)(lds + ML_AV + lane * 96 + 64) = (u32x4){f2bf(SC[256 + lane]), 0u, 0u, 0u}; *(LAS u32x4*)(lds + ML_AV + lane * 96 + 80) = (u32x4){0u, 0u, 0u, 0u};
        }
        {
            const int tt = wave >> 1;
#pragma unroll
            for (int u = 0; u < 2; ++u) {
                const int st = 2 * (wave & 1) + u;
                f32x4 a = {0.f, 0.f, 0.f, 0.f};
                if (st <= tt) {
#pragma unroll
                    for (int ks = 0; ks < 8; ++ks) {
                        const bf16x8 kf = *(const LAS bf16x8*)(lds + ML_KS + (16 * st + fr) * ML_P + 64 * ks + 16 * fq);
                        const bf16x8 qf = *(const LAS bf16x8*)(lds + ML_QS + (16 * tt + fr) * ML_P + 64 * ks + 16 * fq);
                        a = MFMA16(kf, qf, a);
                    }
                }
                const int t = 16 * tt + fr; const float bmt = SC[64 + t];
                float w[4];
#pragma unroll
                for (int i = 0; i < 4; ++i) { const int s2 = 16 * st + 4 * fq + i; w[i] = (s2 <= t) ? __expf(bmt + SC[s2]) * a[i] : 0.f; }
                u32x2 o; o.x = pk2(w[0], w[1]); o.y = pk2(w[2], w[3]);
                *(LAS u32x2*)(lds + ML_WW + t * 144 + (16 * st + 4 * fq) * 2) = o;
            }
        }
        __syncthreads();
#if defined(MLV) && (MLV & 1)
        for (int tile = wave; tile < 12; tile += 8) {
            const int tt = tile & 3, vt = tile >> 2;
            f32x4 aw = {0.f, 0.f, 0.f, 0.f}, ac = {0.f, 0.f, 0.f, 0.f};
#pragma unroll
            for (int k2 = 0; k2 < 2; ++k2) {
                const bf16x8 wf = *(const LAS bf16x8*)(lds + ML_WW + (16 * tt + fr) * 144 + 64 * k2 + 16 * fq);
                const LAS unsigned char* vp = lds + ML_VE + (32 * k2 + 8 * fq + tq) * 96 + (16 * vt + 4 * tp) * 2;
                aw = MFMA16(wf, cat8(vtr(vp), vtr(vp + 4 * 96)), aw);
            }
#pragma unroll
            for (int ks = 0; ks < 8; ++ks) {
                const bf16x8 qf = *(const LAS bf16x8*)(lds + ML_QS + (16 * tt + fr) * ML_P + 64 * ks + 16 * fq);
                const bf16x8 cf = *(const LAS bf16x8*)(lds + ML_CB + (16 * vt + fr) * ML_P + 64 * ks + 16 * fq);
                ac = MFMA16(qf, cf, ac);
            }
#pragma unroll
            for (int i = 0; i < 4; ++i) { const int t = 16 * tt + 4 * fq + i; ((LAS float*)(lds + ML_NUM))[t * 52 + 16 * vt + fr] = aw[i] + SC[128 + t] * ac[i]; }
        }
#else
        {
            const int tt = wave & 3, hf = wave >> 2;
            f32x4 aw[3], ac[3];
#pragma unroll
            for (int vt = 0; vt < 3; ++vt) { aw[vt] = (f32x4){0.f, 0.f, 0.f, 0.f}; ac[vt] = (f32x4){0.f, 0.f, 0.f, 0.f}; }
            {
                const bf16x8 wf = *(const LAS bf16x8*)(lds + ML_WW + (16 * tt + fr) * 144 + 64 * hf + 16 * fq);
#pragma unroll
                for (int vt = 0; vt < 3; ++vt) {
                    const LAS unsigned char* vp = lds + ML_VE + (32 * hf + 8 * fq + tq) * 96 + (16 * vt + 4 * tp) * 2;
                    aw[vt] = MFMA16(wf, cat8(vtr(vp), vtr(vp + 4 * 96)), aw[vt]);
                }
            }
#pragma unroll
            for (int k4 = 0; k4 < 4; ++k4) {
                const int ks = 4 * hf + k4;
                const bf16x8 qf = *(const LAS bf16x8*)(lds + ML_QS + (16 * tt + fr) * ML_P + 64 * ks + 16 * fq);
#pragma unroll
                for (int vt = 0; vt < 3; ++vt) {
                    const bf16x8 cf = *(const LAS bf16x8*)(lds + ML_CB + (16 * vt + fr) * ML_P + 64 * ks + 16 * fq);
                    ac[vt] = MFMA16(qf, cf, ac[vt]);
                }
            }
#pragma unroll
            for (int i = 0; i < 4; ++i) { const int t = 16 * tt + 4 * fq + i; const float in = SC[128 + t];
#pragma unroll
                for (int vt = 0; vt < 3; ++vt) atomicAdd((float*)((LAS float*)(lds + ML_NUM) + t * 52 + 16 * vt + fr), aw[vt][i] + in * ac[vt][i]); }
        }
#endif
        __syncthreads();
        {
            const int t = tid >> 3, v4 = (tid & 7) * 4;
            const LAS float* nr = (const LAS float*)(lds + ML_NUM) + t * 52;
            const float den = fmaxf(fabsf(nr[32]), SC[192 + t]); const float inv = 1.0f / den;
            const f32x4 nv = *(const LAS f32x4*)(nr + v4);
            u32x2 o; o.x = pk2(nv[0] * inv, nv[1] * inv); o.y = pk2(nv[2] * inv, nv[3] * inv);
            *(u32x2*)(HPRE + (rowb + t0 + t) * 1024 + h * 256 + sl * 32 + v4) = o;
        }
        {
            const float decay = SC[320];
#pragma unroll
            for (int a = 0; a < 2; ++a) {
                const int kt = 2 * wave + a;
                bf16x8 kf[2];
#pragma unroll
                for (int k2 = 0; k2 < 2; ++k2) {
                    const LAS unsigned char* kp = lds + ML_KS + (32 * k2 + 8 * fq + tq) * ML_P + (16 * kt + 4 * tp) * 2;
                    kf[k2] = cat8(vtr(kp), vtr(kp + 4 * ML_P));
                }
#pragma unroll
                for (int vt = 0; vt < 3; ++vt) {
                    f32x4 acc = cacc[a][vt] * decay;
#pragma unroll
                    for (int k2 = 0; k2 < 2; ++k2) {
                        const LAS unsigned char* vp = lds + ML_AV + (32 * k2 + 8 * fq + tq) * 96 + (16 * vt + 4 * tp) * 2;
                        acc = MFMA16(kf[k2], cat8(vtr(vp), vtr(vp + 4 * 96)), acc);
                    }
                    cacc[a][vt] = acc;
                    u32x2 o; o.x = pk2(acc[0], acc[1]); o.y = pk2(acc[2], acc[3]);
                    *(LAS u32x2*)(lds + ML_CB + (16 * vt + fr) * ML_P + (16 * kt + 4 * fq) * 2) = o;
                }
            }
        }
        __syncthreads();
    }
#undef ML_PREFETCH
}

#define XB_TMO      128
#define XB_XCNT(j)  (256  + 64 * (j))
#define XB_XSUB(j)  (1280 + 64 * (j))
#define XB_XGEN(j)  (2304 + 64 * (j))
#define XB_TOP      3328
#define XB_TOPGEN   3392
#define XCD_BAR_WORDS 3456
#define XB_SPIN_CAP (1u << 18)

__device__ __forceinline__ unsigned xb_ld(unsigned* p)              { return __hip_atomic_load(p, __ATOMIC_RELAXED, __HIP_MEMORY_SCOPE_AGENT); }
__device__ __forceinline__ unsigned xb_add(unsigned* p, unsigned v) { return __hip_atomic_fetch_add(p, v, __ATOMIC_RELAXED, __HIP_MEMORY_SCOPE_AGENT); }
__device__ __forceinline__ unsigned xb_xcc_id() { return (unsigned)__builtin_amdgcn_s_getreg((3 << 11) | 20) & 0xFu; }
#define XB_SPIN(cond, bar) do { unsigned _sp = 0; while (cond) { __builtin_amdgcn_s_sleep(1); \
    if ((++_sp & 255u) == 0u) { if (xb_ld(&(bar)[XB_TMO])) break; if (_sp > XB_SPIN_CAP) { atomicAdd(&(bar)[XB_TMO], 1u); break; } } } } while (0)

struct XcdBarrier {
    unsigned* bar; unsigned x;
    volatile LAS unsigned* st;
};

__device__ __forceinline__ XcdBarrier xcd_barrier_post(unsigned* bar, volatile LAS unsigned* st) {
    XcdBarrier b; b.bar = bar; b.x = xb_xcc_id(); b.st = st;
    if (threadIdx.x == 0) (void)xb_add(&bar[XB_XCNT(b.x)], 1u);
    return b;
}
__device__ __forceinline__ void xcd_barrier_complete(unsigned* bar, unsigned x, unsigned& nloc, unsigned& nx) {
    const unsigned G = gridDim.x * gridDim.y * gridDim.z;
    unsigned sum, cnt, mine, sp = 0u;
    for (;;) {
        sum = 0u; cnt = 0u; mine = 0u;
#pragma unroll
        for (unsigned j = 0; j < 16; ++j) { const unsigned c = xb_ld(&bar[XB_XCNT(j)]); sum += c; cnt += (c > 0u) ? 1u : 0u; mine = (j == x) ? c : mine; }
        if (sum == G) break;
        __builtin_amdgcn_s_sleep(1);
        if ((++sp & 255u) == 0u) { if (xb_ld(&bar[XB_TMO])) break; if (sp > XB_SPIN_CAP) { atomicAdd(&bar[XB_TMO], 1u); break; } }
    }
    nloc = mine > 0u ? mine : 1u; nx = cnt > 0u ? cnt : 1u;
}

__device__ __forceinline__ void xcd_barrier(const XcdBarrier& b) {
    asm volatile("s_waitcnt vmcnt(0)" ::: "memory");
    __syncthreads();
    if (threadIdx.x == 0) {
        unsigned* bar = b.bar;
        __builtin_amdgcn_s_waitcnt(0);
        unsigned nloc = b.st[0], nx = b.st[1];
        if (nloc == 0u) { xcd_barrier_complete(bar, b.x, nloc, nx); b.st[0] = nloc; b.st[1] = nx; }
        const unsigned old = xb_add(&bar[XB_XSUB(b.x)], 1u);
        const unsigned gen = old / nloc;
        if (old + 1u == (gen + 1u) * nloc) {
            __builtin_amdgcn_fence(__ATOMIC_RELEASE, "agent");
            asm volatile("s_waitcnt vmcnt(0)" ::: "memory");
            const unsigned og = xb_add(&bar[XB_TOP], 1u);
            const unsigned tg = og / nx;
            if (og + 1u == (tg + 1u) * nx) xb_add(&bar[XB_TOPGEN], 1u);
            else XB_SPIN(xb_ld(&bar[XB_TOPGEN]) == tg, bar);
            __builtin_amdgcn_fence(__ATOMIC_ACQUIRE, "agent");
            xb_add(&bar[XB_XGEN(b.x)], 1u);
            asm volatile("s_waitcnt vmcnt(0)" ::: "memory");
        } else {
            XB_SPIN(xb_ld(&bar[XB_XGEN(b.x)]) == gen, bar);
            __builtin_amdgcn_fence(__ATOMIC_ACQUIRE, "agent");
            asm volatile("s_waitcnt vmcnt(0)" ::: "memory");
        }
    }
    __syncthreads();
}

#define grid_seam() xcd_barrier(bar)

__global__ void __launch_bounds__(512, 2) hybrid_fwd(Args args) {
    extern __shared__ __attribute__((aligned(16))) unsigned char lds_raw[];
    LAS unsigned char* lds = (LAS unsigned char*)lds_raw;

    const int tid = threadIdx.x, lane = tid & 63, wave = __builtin_amdgcn_readfirstlane(tid >> 6);
    const int G = gridDim.x, bid = blockIdx.x;
    const int gw = bid * 8 + wave, ngw = G * 8;
    unsigned char* ws = args.ws;
    if (tid < 2) ((LAS unsigned*)(lds + RING_BYTES))[tid] = 0u;
    __syncthreads();
    cg::this_grid().sync();
    XcdBarrier bar = xcd_barrier_post((unsigned*)ws, (volatile LAS unsigned*)(lds + RING_BYTES));
    const float* x = args.in[0];
    float* X = args.out;
    bf16_t* WGU1 = (bf16_t*)(ws + WS_WGU1); bf16_t* WD1 = (bf16_t*)(ws + WS_WD1); bf16_t* WGU2 = (bf16_t*)(ws + WS_WGU2); bf16_t* WD2 = (bf16_t*)(ws + WS_WD2);
    bf16_t* WIN = (bf16_t*)(ws + WS_WIN); bf16_t* WA = (bf16_t*)(ws + WS_WA); bf16_t* WM = (bf16_t*)(ws + WS_WM); bf16_t* WO = (bf16_t*)(ws + WS_WO);
    bf16_t* H = (bf16_t*)(ws + WS_H); bf16_t* ACT = (bf16_t*)(ws + WS_ACT); bf16_t* F = (bf16_t*)(ws + WS_F);
    bf16_t* Qb = (bf16_t*)(ws + WS_Q); bf16_t* ATT = (bf16_t*)(ws + WS_ATT); bf16_t* QKMV = (bf16_t*)(ws + WS_QKMV); bf16_t* HPRE = (bf16_t*)(ws + WS_HPRE);
    bf16_t* OG = (bf16_t*)(ws + WS_OG); bf16_t* Y = (bf16_t*)(ws + WS_Y);
    float* IF = (float*)(ws + WS_IF); float* LSE = (float*)(ws + WS_LSE); float* ROPE = (float*)(ws + WS_ROPE); float* GT = (float*)(ws + WS_GT);

    {
        LAS float* scr = (LAS float*)(lds + wave * 16384);
        constexpr int I_G = 16 * 88, I_D = 44 * 32, I_INA = 16 * 272, I_INB = 16 * 64, I_A = 8 * 32, I_M = 16 * 32;
        constexpr int NIT = 6 * I_G + I_INA + I_INB + I_A + 2 * I_M;
        for (int it = gw; it < NIT; it += ngw) {
            int r = it;
            if (r < 4 * I_G) {
                const int w = r / I_G; r -= w * I_G; const int kb = r / 88, nb = r % 88;
                const float* src = args.in[w == 0 ? 2 : w == 1 ? 3 : w == 2 ? 18 : 19];
                tr_item(src, DFF, 32 * nb, 64 * kb, (w < 2) ? WGU1 : WGU2, 1024, 256 * (nb >> 2) + 32 * (nb & 3) + 128 * (w & 1), scr, lane); continue; }
            r -= 4 * I_G;
            if (r < 2 * I_D) {
                const int w = r / I_D; r -= w * I_D; const int kb = r / 32, nb = r % 32;
                tr_item(args.in[w == 0 ? 4 : 20], 1024, 32 * nb, 64 * kb, w == 0 ? WD1 : WD2, DFF, 32 * nb, scr, lane); continue; }
            r -= 2 * I_D;
            if (r < I_INA) { const int kb = r / 272, nb = r % 272; tr_item(args.in[7], INW, 32 * nb, 64 * kb, WIN, 1024, 32 * nb, scr, lane); continue; }
            r -= I_INA;
            if (r < I_INB) { const int kb = r / 64, nb = r % 64; tr_item(args.in[7], INW, 8712 + 32 * nb, 64 * kb, WIN, 1024, 8704 + 32 * nb, scr, lane); continue; }
            r -= I_INB;
            if (r < I_A) { const int kb = r / 32, nb = r % 32; tr_item(args.in[13], 1024, 32 * nb, 64 * kb, WA, 512, 32 * nb, scr, lane); continue; }
            r -= I_A;
            if (r < I_M) { const int kb = r / 32, nb = r % 32; tr_item(args.in[14], 1024, 32 * nb, 64 * kb, WM, 1024, 32 * nb, scr, lane); continue; }
            r -= I_M;
            { const int kb = r / 32, nb = r % 32; tr_item(args.in[15], 1024, 32 * nb, 64 * kb, WO, 1024, 32 * nb, scr, lane); }
        }
        for (int id = bid * 512 + tid; id < 2048 * 16; id += G * 512) {
            const int pos = id >> 4, i = id & 15;
            const float invf = powf(500000.0f, -((float)i * 2.0f / 32.0f));
            const float ang = (float)pos * invf;
            const double a = (double)ang; const double k = rint(a * 0.15915494309189535); const float rr = (float)(a - k * 6.283185307179586);
            ROPE[2 * id] = cosf(rr); ROPE[2 * id + 1] = sinf(rr);
        }
        rowpass<false, false, true, false>(gw, ngw, lane, x, nullptr, 0.f, nullptr, nullptr, args.in[1], H, nullptr, nullptr);
    }
    grid_seam();
    { pg8::Gemm g{H, WGU1, M, 5632, 1024}; pg8::StaticOrder S; S.init(M, 5632, G, bid); pg8::Epi<1> E{ACT, DFF, nullptr, 0, 0, nullptr, 1.f, 0};
      pg8::gemm_phase<pg8::Epi<1>, pg8::StaticOrder, true, true>(lds, g, S, E); }
    grid_seam();
    { pg8::Gemm g{ACT, WD1, M, 1024, DFF}; pg8::StaticOrder S; S.init(M, 1024, G, bid); pg8::Epi<0> E{F, 1024, nullptr, 0, 0, nullptr, 1.f, 0};
      pg8::gemm_phase<pg8::Epi<0>, pg8::StaticOrder, true, true>(lds, g, S, E); }
    grid_seam();
    {
        LAS f32x4* wif = (LAS f32x4*)lds;
        const float* win = args.in[7];
        for (int i = tid; i < 32 * 64; i += 512) { const int ln = i & 63, q = i >> 6, half = q & 1, e = (q >> 1) & 3, j = q >> 3; const int k = 4 * ln + e + 256 * j;
            const float* p = win + (size_t)k * INW + 8704 + 4 * half; wif[i] = (f32x4){p[0], p[1], p[2], p[3]}; }
        __syncthreads();
        rowpass<true, true, true, true>(gw, ngw, lane, x, F, 0.5f, args.in[5], X, args.in[6], H, wif, IF);
        __syncthreads();
    }
    grid_seam();
#if !defined(VAR) || VAR != 1
    { pg8::Gemm g{H, WIN, M, 4608, 1024}; pg8::StaticOrder S; S.init(M, 4608, G, bid);
      pg8::Epi<3> E{Qb, 1536, nullptr, 0, 0, ROPE, 0.08838834764831845f * 1.4426950408889634f, (size_t)M * 1536};
      pg8::gemm_phase<pg8::Epi<3>, pg8::StaticOrder, true, true>(lds, g, S, E); }
    grid_seam();
    for (int it = bid; it < 1536; it += G) attn_item(lds, Qb, Qb + (size_t)M * 1536, Qb + (size_t)2 * M * 1536, LSE, it, tid, wave, lane);
    grid_seam();
    if (bid < 32) gates_prepass(lds, IF, args.in[10], args.in[11], GT, bid, tid, wave, lane);
    for (int row = gw; row < M; row += ngw) {
        const int slot = lane >> 4;
        const float l0 = LSE[(size_t)row * 12 + slot], l1 = LSE[(size_t)row * 12 + 4 + slot], l2 = LSE[(size_t)row * 12 + 8 + slot];
        const float mx = fmaxf(l0, fmaxf(l1, l2));
        float e0 = __expf(l0 - mx), e1 = __expf(l1 - mx), e2 = __expf(l2 - mx); const float inv = 1.0f / (e0 + e1 + e2); e0 *= inv; e1 *= inv; e2 *= inv;
        f32x4 a0, a1, b0, b1, c0, c1;
        pg8::load8(Qb + (size_t)row * 1536 + 8 * lane, a0, a1); pg8::load8(Qb + (size_t)row * 1536 + 512 + 8 * lane, b0, b1); pg8::load8(Qb + (size_t)row * 1536 + 1024 + 8 * lane, c0, c1);
        pg8::store8(ATT + (size_t)row * 512 + 8 * lane, a0 * e0 + b0 * e1 + c0 * e2, a1 * e0 + b1 * e1 + c1 * e2);
    }
    { pg8::Gemm g{H, WIN + (size_t)4608 * 1024, M, 3072, 1024}; pg8::StaticOrder S; S.init(M, 3072, G, bid); pg8::Epi<0> E{QKMV, 3072, nullptr, 0, 0, nullptr, 1.f, 0};
      pg8::gemm_phase<pg8::Epi<0>, pg8::StaticOrder, true, true>(lds, g, S, E); }
    grid_seam();
    { ConvHalo CH; conv_halo(QKMV, bid * 512 + tid, CH); grid_seam(); conv_run(QKMV, args.in[8], args.in[9], bid * 512 + tid, CH); }
    grid_seam();
#if defined(VAR) && VAR == 4
    for (int row = gw; row < M; row += ngw) { const u32x4 a = *(const u32x4*)(QKMV + (size_t)row * 3072 + 2048 + 16 * lane), b2 = *(const u32x4*)(QKMV + (size_t)row * 3072 + 2048 + 16 * lane + 8);
        *(u32x4*)(HPRE + (size_t)row * 1024 + 16 * lane) = a; *(u32x4*)(HPRE + (size_t)row * 1024 + 16 * lane + 8) = b2; }
#elif !defined(VAR) || VAR != 2
    for (int it = bid; it < 256; it += G) mlstm_item(lds, QKMV, GT, HPRE, it, tid, wave, lane);
#endif
#if defined(DUP) && (DUP & 1)
    grid_seam();
    for (int it = bid; it < 256; it += G) mlstm_item(lds, QKMV, GT, HPRE, it, tid, wave, lane);
#endif
    grid_seam();
    { pg8::Gemm g{H, WIN + (size_t)7680 * 1024, M, 3072, 1024}; pg8::StaticOrder S; S.init(M, 3072, G, bid); pg8::Epi<2> E{OG, 3072, nullptr, 0, 0, nullptr, 1.f, 0};
      pg8::gemm_phase<pg8::Epi<2>, pg8::StaticOrder, true, true>(lds, g, S, E); }
    grid_seam();
#if !defined(VAR) || VAR != 2
    {
        const float* hg = args.in[12];
        for (int row = gw; row < M; row += ngw) {
            bf16_t* hp = HPRE + (size_t)row * 1024 + 16 * lane;
            f32x4 v[4], o[4];
            pg8::load8(hp, v[0], v[1]); pg8::load8(hp + 8, v[2], v[3]);
            pg8::load8(OG + (size_t)row * 3072 + 16 * lane, o[0], o[1]); pg8::load8(OG + (size_t)row * 3072 + 16 * lane + 8, o[2], o[3]);
            float ss = 0.f;
#pragma unroll
            for (int j = 0; j < 4; ++j) ss += (v[j][0] * v[j][0] + v[j][1] * v[j][1]) + (v[j][2] * v[j][2] + v[j][3] * v[j][3]);
            ss += __shfl_xor(ss, 1); ss += __shfl_xor(ss, 2); ss += __shfl_xor(ss, 4); ss += __shfl_xor(ss, 8);
            const float rstd = __builtin_amdgcn_rsqf(ss * (1.0f / 256.0f) + EPS);
#pragma unroll
            for (int j = 0; j < 4; ++j) { const f32x4 gg = *(const f32x4*)(hg + 16 * lane + 4 * j); v[j] = v[j] * gg * o[j] * rstd; }
            pg8::store8(hp, v[0], v[1]); pg8::store8(hp + 8, v[2], v[3]);
        }
    }
#endif
    { pg8::Gemm g{ATT, WA, M, 1024, 512}; pg8::StaticOrder S; S.init(M, 1024, G, bid); pg8::Epi<4> E{H, 1024, OG, 3072, 1024, nullptr, 1.f, 0};
      pg8::gemm_phase<pg8::Epi<4>, pg8::StaticOrder, true, true>(lds, g, S, E); }
    grid_seam();
#if !defined(VAR) || VAR != 2
    { pg8::Gemm g{HPRE, WM, M, 1024, 1024}; pg8::StaticOrder S; S.init(M, 1024, G, bid); pg8::Epi<5> E{H, 1024, OG, 3072, 2048, nullptr, 1.f, 0};
      pg8::gemm_phase<pg8::Epi<5>, pg8::StaticOrder, true, true>(lds, g, S, E); }
#endif
    grid_seam();
    { pg8::Gemm g{H, WO, M, 1024, 1024}; pg8::StaticOrder S; S.init(M, 1024, G, bid); pg8::Epi<0> E{Y, 1024, nullptr, 0, 0, nullptr, 1.f, 0};
      pg8::gemm_phase<pg8::Epi<0>, pg8::StaticOrder, true, true>(lds, g, S, E); }
    grid_seam();
#endif
#if defined(VAR) && VAR == 1
    rowpass<false, false, true, false>(gw, ngw, lane, X, nullptr, 0.f, nullptr, nullptr, args.in[17], H, nullptr, nullptr);
#else
    rowpass<true, true, true, false>(gw, ngw, lane, X, Y, 1.0f, args.in[16], X, args.in[17], H, nullptr, nullptr);
#endif
    grid_seam();
    { pg8::Gemm g{H, WGU2, M, 5632, 1024}; pg8::StaticOrder S; S.init(M, 5632, G, bid); pg8::Epi<1> E{ACT, DFF, nullptr, 0, 0, nullptr, 1.f, 0};
      pg8::gemm_phase<pg8::Epi<1>, pg8::StaticOrder, true, true>(lds, g, S, E); }
    grid_seam();
    { pg8::Gemm g{ACT, WD2, M, 1024, DFF}; pg8::StaticOrder S; S.init(M, 1024, G, bid); pg8::Epi<0> E{F, 1024, nullptr, 0, 0, nullptr, 1.f, 0};
      pg8::gemm_phase<pg8::Epi<0>, pg8::StaticOrder, true, true>(lds, g, S, E); }
    grid_seam();
    rowpass<true, true, false, false>(gw, ngw, lane, X, F, 0.5f, args.in[21], X, nullptr, nullptr, nullptr, nullptr);
}

extern "C" void kernel_launch(void* const* d_in, const int* in_sizes, int n_in, void* d_out, int out_size, void* d_ws, size_t ws_size, hipStream_t stream) {
    static int grid = 0;
    if (grid == 0) {
        if (n_in != 22 || out_size != M * DM || ws_size < WS_END) { fprintf(stderr, "kernel_launch: unexpected shapes (n_in %d out %d ws %zu)\n", n_in, out_size, ws_size); grid = -1; return; }
        int dev = 0, cus = 0, per_cu = 0;
        hipGetDevice(&dev);
        hipDeviceGetAttribute(&cus, hipDeviceAttributeMultiprocessorCount, dev);
        if (hipFuncSetAttribute((const void*)hybrid_fwd, hipFuncAttributeMaxDynamicSharedMemorySize, LDS_BYTES) != hipSuccess) { fprintf(stderr, "kernel_launch: hipFuncSetAttribute failed\n"); grid = -1; return; }
        if (hipOccupancyMaxActiveBlocksPerMultiprocessor(&per_cu, (const void*)hybrid_fwd, 512, LDS_BYTES) != hipSuccess || per_cu < 1) { fprintf(stderr, "kernel_launch: occupancy query says %d\n", per_cu); per_cu = 1; }
        (void)hipGetLastError();
        grid = cus;
        if (grid > 256) grid = 256;
    }
    if (grid < 0) return;
    Args a{};
    for (int i = 0; i < 22; ++i) a.in[i] = (const float*)d_in[i];
    a.out = (float*)d_out; a.ws = (unsigned char*)d_ws;
    if (hipMemsetAsync(d_ws, 0, 16384, stream) != hipSuccess) { fprintf(stderr, "memset failed\n"); return; }
    void* kargs[] = {&a};
    hipError_t e = hipLaunchCooperativeKernel((const void*)hybrid_fwd, dim3(grid), dim3(512), kargs, LDS_BYTES, stream);
    if (e != hipSuccess) fprintf(stderr, "cooperative launch failed: %s (grid %d)\n", hipGetErrorString(e), grid);
}
```

```cpp
#define MLV 1
#include <hip/hip_runtime.h>
#include <hip/hip_cooperative_groups.h>
#include <cstdio>
#include <cstdint>
namespace cg = cooperative_groups;
namespace pg8 {
#define PG8_LAS __attribute__((address_space(3)))
typedef unsigned short bf16_t;
typedef short bf16x8 __attribute__((ext_vector_type(8)));
typedef float f32x4 __attribute__((ext_vector_type(4)));
typedef unsigned u32x4 __attribute__((ext_vector_type(4)));
constexpr int BM = 256, BK = 64, HALF = 128, HTB = HALF * BK * 2  , STAGE_BYTES = 8 * HTB, NXCD = 8, WGM = 8;

__host__ __device__ __forceinline__ int lds_byte(int r, int c) { const int st = (r >> 4) * 2 + (c >> 5), rr = r & 15, cc = c & 31, ob = rr * 64 + cc * 2; return st * 1024 + (ob ^ (((ob >> 9) & 1) << 5)); }
__host__ __device__ __forceinline__ void stage_rc(int b, int& R, int& C) { const int st = b / 1024, sb = b % 1024, swz = sb ^ (((sb >> 9) & 1) << 5); R = (st >> 1) * 16 + swz / 64; C = (st & 1) * 32 + (swz % 64) / 2; }
__host__ __device__ __forceinline__ int perm32(int rho) { const int n = rho >> 4, i = rho & 15; return 8 * (i >> 2) + 4 * n + (i & 3); }

struct Unit { int pm, pn; };
struct Gemm { const bf16_t* A; const bf16_t* Bt; int M, N, K; };

struct StaticOrder {
    int nM, nN, nwg, G, c;
    __host__ __device__ void init(int M, int N, int G_, int c_) { nM = M / BM; nN = N / BM; nwg = nM * nN; G = G_; c = c_; }
    __host__ __device__ bool next(int i, Unit& u) const {
        const long L = (long)i * G + c; if (L >= nwg) return false;
        int wgid = (int)L; { const int q = nwg / NXCD, r = nwg % NXCD, xcd = wgid % NXCD, off = wgid / NXCD; wgid = (xcd < r ? xcd * (q + 1) : r * (q + 1) + (xcd - r) * q) + off; }
        const int nig = WGM * nN, gid = wgid / nig, fm = gid * WGM, gsz = (nM - fm) < WGM ? (nM - fm) : WGM;
        u.pm = fm + ((wgid % nig) % gsz); u.pn = (wgid % nig) / gsz; return true;
    }
    __device__ __forceinline__ void a_ready(const Unit&) const {}
    __device__ __forceinline__ void done(const Unit&) const {}
};

typedef float f32x2c_t __attribute__((ext_vector_type(2))); typedef __bf16 bf16x2c_t __attribute__((ext_vector_type(2)));
__device__ __forceinline__ unsigned cvt_pk_bf16(float lo, float hi) { const f32x2c_t v = {lo, hi}; const bf16x2c_t b = __builtin_convertvector(v, bf16x2c_t); return __builtin_bit_cast(unsigned, b); }
typedef float f32x2 __attribute__((ext_vector_type(2)));
typedef unsigned u32x2 __attribute__((ext_vector_type(2)));
__device__ __forceinline__ float sigmoidf_(float x) { return __builtin_amdgcn_rcpf(1.0f + __expf(-x)); }
__device__ __forceinline__ void store8(bf16_t* p, const f32x4 v0, const f32x4 v1) {
    u32x4 w; w.x = cvt_pk_bf16(v0[0], v0[1]); w.y = cvt_pk_bf16(v0[2], v0[3]); w.z = cvt_pk_bf16(v1[0], v1[1]); w.w = cvt_pk_bf16(v1[2], v1[3]); *(u32x4*)p = w;
}
__device__ __forceinline__ void load8(const bf16_t* p, f32x4& v0, f32x4& v1) {
    const u32x4 w = *(const u32x4*)p;
    v0[0] = __uint_as_float(w.x << 16); v0[1] = __uint_as_float(w.x & 0xffff0000u); v0[2] = __uint_as_float(w.y << 16); v0[3] = __uint_as_float(w.y & 0xffff0000u);
    v1[0] = __uint_as_float(w.z << 16); v1[1] = __uint_as_float(w.z & 0xffff0000u); v1[2] = __uint_as_float(w.w << 16); v1[3] = __uint_as_float(w.w & 0xffff0000u);
}
template <int MODE> struct Epi {
    static constexpr bool PERM = true, AFTER_DRAIN = false;
    bf16_t* O; int ldc; const bf16_t* G; int ldg; int gcol; const float* rope; float qscale; size_t split_stride;
    __device__ __forceinline__ void operator()(const f32x4 (&acc)[2][2][4][2], const Unit& u, int wr, int wc, int fr, int fq) const {
        const int row0 = u.pm * BM + wr * 64 + fr;
        if constexpr (MODE == 1) {
            const int col0 = u.pn * HALF + wc * 32 + 8 * fq;
#pragma unroll
            for (int ai = 0; ai < 2; ++ai)
#pragma unroll
                for (int m = 0; m < 4; ++m) {
                    f32x4 o[2];
#pragma unroll
                    for (int n = 0; n < 2; ++n)
#pragma unroll
                        for (int i = 0; i < 4; ++i) { const float g = acc[ai][0][m][n][i], up = acc[ai][1][m][n][i]; o[n][i] = g * sigmoidf_(g) * up; }
                    store8(O + (size_t)(row0 + ai * HALF + m * 16) * ldc + col0, o[0], o[1]);
                }
        } else if constexpr (MODE == 3) {
            const int colt = u.pn * BM; const int t = colt / 1536;
            bf16_t* base = O + (size_t)t * split_stride;
            const int lc = colt - t * 1536 + wc * 32 + 8 * fq;
            const bool rp = (t < 2) && (wc == 0);
            const float sc = (t == 0) ? qscale : 1.0f;
            const float sgn = (fq < 2) ? -1.0f : 1.0f;
            float rf[2][4];
#pragma unroll
            for (int n = 0; n < 2; ++n)
#pragma unroll
                for (int i = 0; i < 4; ++i) rf[n][i] = __builtin_amdgcn_exp2f(-(float)(8 * (fq & 1) + 4 * n + i) * (18.931568569324174f / 16.0f)) * 0.15915494309189535f;
#pragma unroll
            for (int ai = 0; ai < 2; ++ai)
#pragma unroll
                for (int m = 0; m < 4; ++m) {
                    const int row = row0 + ai * HALF + m * 16;
                    f32x4 cs[2][2];
                    if (rp) {
                        const float pos = (float)(row & 2047);
#pragma unroll
                        for (int n = 0; n < 2; ++n)
#pragma unroll
                            for (int i = 0; i < 4; ++i) { const float rv = __builtin_amdgcn_fractf(pos * rf[n][i]); cs[n][i >> 1][2 * (i & 1)] = __builtin_amdgcn_cosf(rv); cs[n][i >> 1][2 * (i & 1) + 1] = __builtin_amdgcn_sinf(rv); }
                    }
#pragma unroll
                    for (int bj = 0; bj < 2; ++bj) {
                        f32x4 o[2];
#pragma unroll
                        for (int n = 0; n < 2; ++n) {
                            f32x4 v = acc[ai][bj][m][n];
                            if (rp) {
                                f32x4 pz;
#pragma unroll
                                for (int i = 0; i < 4; ++i) { const unsigned own = __float_as_uint(v[i]); auto sw = __builtin_amdgcn_permlane32_swap(own, own, false, false);
                                    pz[i] = __uint_as_float(sw[0] ^ sw[1] ^ own); }
                                v[0] = v[0] * cs[n][0][0] + sgn * pz[0] * cs[n][0][1];
                                v[1] = v[1] * cs[n][0][2] + sgn * pz[1] * cs[n][0][3];
                                v[2] = v[2] * cs[n][1][0] + sgn * pz[2] * cs[n][1][1];
                                v[3] = v[3] * cs[n][1][2] + sgn * pz[3] * cs[n][1][3];
                            }
                            o[n] = v * sc;
                        }
                        store8(base + (size_t)row * ldc + lc + bj * HALF, o[0], o[1]);
                    }
                }
        } else {
            const int col0 = u.pn * BM + wc * 32 + 8 * fq;
#pragma unroll
            for (int ai = 0; ai < 2; ++ai)
#pragma unroll
                for (int m = 0; m < 4; ++m) {
                    const int row = row0 + ai * HALF + m * 16;
#pragma unroll
                    for (int bj = 0; bj < 2; ++bj) {
                        f32x4 v0 = acc[ai][bj][m][0], v1 = acc[ai][bj][m][1];
                        bf16_t* op = O + (size_t)row * ldc + col0 + bj * HALF;
                        if constexpr (MODE == 2) {
#pragma unroll
                            for (int i = 0; i < 4; ++i) { v0[i] = sigmoidf_(v0[i]); v1[i] = sigmoidf_(v1[i]); }
                        }
                        if constexpr (MODE == 4 || MODE == 5) {
                            f32x4 g0, g1; load8(G + (size_t)row * ldg + gcol + col0 + bj * HALF, g0, g1);
                            v0 = v0 * g0; v1 = v1 * g1;
                            if constexpr (MODE == 5) { f32x4 t0, t1; load8(op, t0, t1); v0 = v0 + t0; v1 = v1 + t1; }
                        }
                        store8(op, v0, v1);
                    }
                }
        }
    }
};
template <class Epi, class Sched, bool ALIGN_EPI = false, bool SP2 = false>
__device__ __forceinline__ void gemm_phase(PG8_LAS unsigned char* lds, const Gemm g, const Sched& S, const Epi& E) {
    int tid_l = threadIdx.x; asm volatile("" : "+v"(tid_l));
    const int tid = tid_l, wid = __builtin_amdgcn_readfirstlane(tid >> 6), lane = tid & 63, wr = wid >> 2, wc = wid & 3, fr = lane & 15, fq = lane >> 4;
    const int K = g.K, nt = K / BK;
    unsigned voffA[2], voffB[2];
#pragma unroll
    for (int i = 0; i < 2; ++i) { int R, C; stage_rc(tid * 16 + i * 8192, R, C); const int Rb = Epi::PERM ? ((R & ~31) + perm32(R & 31)) : R;
        voffA[i] = (unsigned)(R * K + C) * 2u; voffB[i] = (unsigned)(Rb * K + C) * 2u; }
    const size_t kstep = (size_t)(BK * 2);
    const size_t hstep = (size_t)HALF * K * 2;
    const size_t tstep = 2 * hstep;
    const unsigned ldsw = (unsigned)wid * 1024u;
    const int aoff = lds_byte(wr * 64 + fr, fq * 8), boff = lds_byte(wc * 32 + fr, fq * 8);
#define PG8_SA(b, h) (((b) * 2 + (h)) * HTB)
#define PG8_SB(b, h) ((4 + (b) * 2 + (h)) * HTB)
#define PG8_STAGE(bufoff, gbase, voff) do { _Pragma("unroll") for (int _i = 0; _i < 2; ++_i) \
        __builtin_amdgcn_global_load_lds((const unsigned*)((const char*)(gbase) + (voff)[_i]), (PG8_LAS unsigned*)(lds + (bufoff) + ldsw + _i * 8192), 16, 0, 0); } while (0)
#define PG8_LDA(dst, b, h) do { _Pragma("unroll") for (int m = 0; m < 4; ++m) _Pragma("unroll") for (int k = 0; k < 2; ++k) dst[m][k] = *(const PG8_LAS bf16x8*)(lds + PG8_SA(b, h) + aoff + m * 2048 + k * 1024); } while (0)
#define PG8_LDB(dst, b, h) do { _Pragma("unroll") for (int n = 0; n < 2; ++n) _Pragma("unroll") for (int k = 0; k < 2; ++k) dst[n][k] = *(const PG8_LAS bf16x8*)(lds + PG8_SB(b, h) + boff + n * 2048 + k * 1024); } while (0)
#define PG8_MMA(ai, bj, At, Bt) do { __builtin_amdgcn_s_setprio(1); _Pragma("unroll") for (int m = 0; m < 4; ++m) _Pragma("unroll") for (int n = 0; n < 2; ++n) _Pragma("unroll") for (int k = 0; k < 2; ++k) \
        acc[ai][bj][m][n] = __builtin_amdgcn_mfma_f32_16x16x32_bf16(Bt[n][k], At[m][k], acc[ai][bj][m][n], 0, 0, 0); __builtin_amdgcn_s_setprio(0); } while (0)
#define PG8_WAIT_V(n) asm volatile("s_waitcnt vmcnt(" #n ")" ::: "memory")
#define PG8_WAIT_L(n) asm volatile("s_waitcnt lgkmcnt(" #n ")" ::: "memory")
#define PG8_BAR __builtin_amdgcn_s_barrier()
#define PG8_SCHED __builtin_amdgcn_sched_barrier(0)
    Unit cur, nxt; int ui = 0;
    if (!S.next(0, cur)) return;
    f32x4 acc[2][2][4][2];
#pragma unroll
    for (int a = 0; a < 2; ++a)
#pragma unroll
        for (int b = 0; b < 2; ++b)
#pragma unroll
            for (int m = 0; m < 4; ++m)
#pragma unroll
                for (int n = 0; n < 2; ++n) acc[a][b][m][n] = (f32x4){0.f, 0.f, 0.f, 0.f};
    bf16x8 At[4][2], B0[2][2], B1[2][2];
    const char* cA = (const char*)g.A + (size_t)cur.pm * tstep; const char* cB = (const char*)g.Bt + (size_t)cur.pn * tstep;
    S.a_ready(cur);
    if constexpr (SP2) {
        PG8_STAGE(PG8_SB(0, 0), cB, voffB); PG8_STAGE(PG8_SB(0, 1), cB + hstep, voffB); PG8_STAGE(PG8_SA(0, 0), cA, voffA); PG8_STAGE(PG8_SA(0, 1), cA + hstep, voffA);
        if (wr == 1) PG8_BAR;
        PG8_WAIT_V(2); PG8_BAR;
        PG8_STAGE(PG8_SB(1, 0), cB + kstep, voffB); PG8_STAGE(PG8_SA(1, 0), cA + kstep, voffA); PG8_STAGE(PG8_SB(1, 1), cB + hstep + kstep, voffB);
        PG8_WAIT_V(6); PG8_BAR;
    } else {
        PG8_STAGE(PG8_SB(0, 0), cB, voffB); PG8_STAGE(PG8_SA(0, 0), cA, voffA); PG8_STAGE(PG8_SB(0, 1), cB + hstep, voffB); PG8_STAGE(PG8_SA(0, 1), cA + hstep, voffA);
        if (wr == 1) PG8_BAR;
        PG8_WAIT_V(4); PG8_BAR;
        PG8_STAGE(PG8_SB(1, 0), cB + kstep, voffB); PG8_STAGE(PG8_SA(1, 0), cA + kstep, voffA); PG8_STAGE(PG8_SB(1, 1), cB + hstep + kstep, voffB);
        PG8_WAIT_V(6); PG8_BAR;
    }
    for (;;) {
        const bool has_next = S.next(ui + 1, nxt);
        const char* nA = has_next ? (const char*)g.A + (size_t)nxt.pm * tstep : cA; const char* nB = has_next ? (const char*)g.Bt + (size_t)nxt.pn * tstep : cB;
        for (int t = 0; t < nt; t += 2) {
            const bool last = (t == nt - 2);
            const char* a1 = cA + (size_t)(t + 1) * kstep;
            const char* a2 = last ? nA : cA + (size_t)(t + 2) * kstep; const char* b2 = last ? nB : cB + (size_t)(t + 2) * kstep;
            const char* a3 = a2 + kstep; const char* b3 = b2 + kstep;
            if (last && has_next) S.a_ready(nxt);
            if constexpr (SP2) {
            PG8_LDB(B0, 0, 0); PG8_LDB(B1, 0, 1); PG8_SCHED; PG8_LDA(At, 0, 0); PG8_STAGE(PG8_SA(1, 1), a1 + hstep, voffA);
            PG8_WAIT_V(8); PG8_WAIT_L(0); PG8_BAR; PG8_MMA(0, 0, At, B0); PG8_MMA(0, 1, At, B1); PG8_BAR; PG8_SCHED;
            PG8_LDA(At, 0, 1); PG8_STAGE(PG8_SB(0, 0), b2, voffB); PG8_STAGE(PG8_SB(0, 1), b2 + hstep, voffB); PG8_STAGE(PG8_SA(0, 0), a2, voffA);
            PG8_WAIT_V(8); PG8_WAIT_L(0); PG8_BAR; PG8_MMA(1, 0, At, B0); PG8_MMA(1, 1, At, B1); PG8_BAR; PG8_SCHED;
            PG8_LDB(B0, 1, 0); PG8_LDB(B1, 1, 1); PG8_SCHED; PG8_LDA(At, 1, 0); PG8_STAGE(PG8_SA(0, 1), a2 + hstep, voffA);
            PG8_WAIT_V(8); PG8_WAIT_L(0); PG8_BAR; PG8_MMA(0, 0, At, B0); PG8_MMA(0, 1, At, B1); PG8_BAR; PG8_SCHED;
            PG8_LDA(At, 1, 1); PG8_STAGE(PG8_SB(1, 0), b3, voffB); PG8_STAGE(PG8_SB(1, 1), b3 + hstep, voffB); PG8_STAGE(PG8_SA(1, 0), a3, voffA);
            PG8_WAIT_V(8); PG8_WAIT_L(0); PG8_BAR; PG8_MMA(1, 0, At, B0); PG8_MMA(1, 1, At, B1); PG8_BAR; PG8_SCHED;
            } else {
            PG8_LDB(B0, 0, 0); PG8_SCHED; PG8_LDA(At, 0, 0); PG8_STAGE(PG8_SA(1, 1), a1 + hstep, voffA);
            PG8_WAIT_L(8); PG8_BAR; PG8_WAIT_L(0); PG8_MMA(0, 0, At, B0); PG8_BAR; PG8_SCHED;
            PG8_LDB(B1, 0, 1); PG8_STAGE(PG8_SB(0, 0), b2, voffB);
            PG8_BAR; PG8_WAIT_L(0); PG8_MMA(0, 1, At, B1); PG8_BAR;
            PG8_LDA(At, 0, 1); PG8_STAGE(PG8_SA(0, 0), a2, voffA);
            PG8_BAR; PG8_WAIT_L(0); PG8_MMA(1, 0, At, B0); PG8_BAR; PG8_SCHED;
            PG8_STAGE(PG8_SB(0, 1), b2 + hstep, voffB);
            PG8_WAIT_V(6); PG8_BAR; PG8_MMA(1, 1, At, B1); PG8_BAR;
            PG8_LDB(B0, 1, 0); PG8_SCHED; PG8_LDA(At, 1, 0); PG8_STAGE(PG8_SA(0, 1), a2 + hstep, voffA);
            PG8_WAIT_L(8); PG8_BAR; PG8_WAIT_L(0); PG8_MMA(0, 0, At, B0); PG8_BAR; PG8_SCHED;
            PG8_LDB(B1, 1, 1); PG8_STAGE(PG8_SB(1, 0), b3, voffB);
            PG8_BAR; PG8_WAIT_L(0); PG8_MMA(0, 1, At, B1); PG8_BAR;
            PG8_LDA(At, 1, 1); PG8_STAGE(PG8_SA(1, 0), a3, voffA);
            PG8_BAR; PG8_WAIT_L(0); PG8_MMA(1, 0, At, B0); PG8_BAR; PG8_SCHED;
            PG8_STAGE(PG8_SB(1, 1), b3 + hstep, voffB);
            PG8_WAIT_V(6); PG8_BAR; PG8_MMA(1, 1, At, B1); PG8_BAR;
            }
        }
        if constexpr (ALIGN_EPI) { if (wr == 0) PG8_BAR; }
        if constexpr (!Epi::AFTER_DRAIN) { E(acc, cur, wr, wc, fr, fq); S.done(cur); }
        if (!has_next) break;
#pragma unroll
        for (int a = 0; a < 2; ++a)
#pragma unroll
            for (int b = 0; b < 2; ++b)
#pragma unroll
                for (int m = 0; m < 4; ++m)
#pragma unroll
                    for (int n = 0; n < 2; ++n) acc[a][b][m][n] = (f32x4){0.f, 0.f, 0.f, 0.f};
        cur = nxt; cA = nA; cB = nB; ++ui;
        if constexpr (ALIGN_EPI) { if (wr == 1) PG8_BAR; }
    }
    PG8_WAIT_V(0);
    if constexpr (!ALIGN_EPI) { if (wr == 0) PG8_BAR; }
    PG8_BAR;
    if constexpr (Epi::AFTER_DRAIN) { E.fused(acc, cur, wr, wc, fr, fq, lds, wid, lane); S.done(cur); }
#undef PG8_SA
#undef PG8_SB
#undef PG8_STAGE
#undef PG8_LDA
#undef PG8_LDB
#undef PG8_MMA
#undef PG8_WAIT_V
#undef PG8_WAIT_L
#undef PG8_BAR
#undef PG8_SCHED
}
}

using pg8::bf16_t; using pg8::bf16x8; using pg8::f32x4; using pg8::u32x4; using pg8::u32x2; using pg8::cvt_pk_bf16;
#define LAS __attribute__((address_space(3)))
typedef short s16x4 __attribute__((ext_vector_type(4)));
constexpr int DM = 1024, BATCH = 8, SEQ = 2048, M = BATCH * SEQ, DFF = 2816, INW = 10760;
constexpr float EPS = 1e-6f;
constexpr size_t MiB = 1u << 20;
constexpr size_t WS_IF = 1 * MiB;
constexpr size_t WS_LSE = WS_IF + 512 * 1024;
constexpr size_t WS_ROPE = WS_LSE + 768 * 1024;
constexpr size_t WS_GT = WS_ROPE + 256 * 1024;
constexpr size_t WS_WGU1 = 4 * MiB;
constexpr size_t WS_WD1 = WS_WGU1 + (size_t)5632 * 1024 * 2;
constexpr size_t WS_WGU2 = WS_WD1 + (size_t)1024 * 2816 * 2;
constexpr size_t WS_WD2 = WS_WGU2 + (size_t)5632 * 1024 * 2;
constexpr size_t WS_WIN = WS_WD2 + (size_t)1024 * 2816 * 2;
constexpr size_t WS_WA = WS_WIN + (size_t)10752 * 1024 * 2;
constexpr size_t WS_WM = WS_WA + (size_t)1024 * 512 * 2;
constexpr size_t WS_WO = WS_WM + (size_t)1024 * 1024 * 2;
constexpr size_t WS_WEND = WS_WO + (size_t)1024 * 1024 * 2;
static_assert(WS_WEND <= 63 * MiB, "weights");
constexpr size_t WS_H = 63 * MiB;
constexpr size_t WS_ACT = 95 * MiB;
constexpr size_t WS_F = 183 * MiB;
constexpr size_t WS_Q = 95 * MiB;
constexpr size_t WS_ATT = 239 * MiB;
constexpr size_t WS_QKMV = 143 * MiB;
constexpr size_t WS_HPRE = 95 * MiB;
constexpr size_t WS_OG = 143 * MiB;
constexpr size_t WS_Y = 143 * MiB;
constexpr size_t WS_END = 256 * MiB;
constexpr int LDS_BYTES = 147456, RING_BYTES = 131072;

struct Args {
    const float* in[22]; float* out; unsigned char* ws;
};

__device__ __forceinline__ float wave_sum(float v) {
#pragma unroll
    for (int o = 1; o < 64; o <<= 1) v += __shfl_xor(v, o);
    return v;
}
__device__ __forceinline__ float wave_max(float v) {
#pragma unroll
    for (int o = 1; o < 64; o <<= 1) v = fmaxf(v, __shfl_xor(v, o));
    return v;
}
__device__ __forceinline__ unsigned f2bf(float f) { unsigned u = __float_as_uint(f); return (u + 0x7fffu + ((u >> 16) & 1u)) >> 16; }
__device__ __forceinline__ unsigned pk2(float lo, float hi) { return cvt_pk_bf16(lo, hi); }
__device__ __forceinline__ float bf_lo(unsigned w) { return __uint_as_float(w << 16); }
__device__ __forceinline__ float bf_hi(unsigned w) { return __uint_as_float(w & 0xffff0000u); }
__device__ __forceinline__ s16x4 vtr(const LAS unsigned char* p) { typedef short v4i16_t __attribute__((ext_vector_type(4))); return __builtin_bit_cast(s16x4, __builtin_amdgcn_ds_read_tr16_b64_v4i16((LAS v4i16_t*)p)); }
__device__ __forceinline__ bf16x8 cat8(s16x4 a, s16x4 b) { return (bf16x8){a[0], a[1], a[2], a[3], b[0], b[1], b[2], b[3]}; }
#define MFMA16(a, b, c) __builtin_amdgcn_mfma_f32_16x16x32_bf16((a), (b), (c), 0, 0, 0)

__device__ __forceinline__ void tr_item(const float* W, int ldw, int col0, int k0, bf16_t* WT, int K, int drow0, LAS float* scr, int lane) {
    const int r8 = lane >> 3, c4 = lane & 7;
    f32x4 v[8];
#pragma unroll
    for (int i = 0; i < 8; ++i) v[i] = *(const f32x4*)(W + (size_t)(k0 + r8 + 8 * i) * ldw + col0 + 4 * c4);
#pragma unroll
    for (int i = 0; i < 8; ++i) { LAS float* d = scr + (r8 + 8 * i) * 33 + 4 * c4; d[0] = v[i][0]; d[1] = v[i][1]; d[2] = v[i][2]; d[3] = v[i][3]; }
    asm volatile("s_waitcnt lgkmcnt(0)" ::: "memory");
    const int c = lane & 7;
#pragma unroll
    for (int j = 0; j < 4; ++j) { const int n = (lane >> 3) + 8 * j; const LAS float* s = scr + (8 * c) * 33 + n;
        u32x4 o; o.x = pk2(s[0 * 33], s[1 * 33]); o.y = pk2(s[2 * 33], s[3 * 33]); o.z = pk2(s[4 * 33], s[5 * 33]); o.w = pk2(s[6 * 33], s[7 * 33]);
        *(u32x4*)(WT + (size_t)(drow0 + n) * K + k0 + 8 * c) = o; }
    asm volatile("s_waitcnt lgkmcnt(0)" ::: "memory");
}

template <bool HAS_BR, bool WRITE_RES, bool WRITE_NORM, bool DO_IF>
__device__ __forceinline__ void rowpass(int gw, int ngw, int lane, const float* res, const bf16_t* br, float coef, const float* gbr, float* outres,
                                        const float* gn, bf16_t* outn, const LAS f32x4* wif, float* IF) {
    for (int row = gw; row < M; row += ngw) {
        f32x4 v[4];
#pragma unroll
        for (int j = 0; j < 4; ++j) v[j] = *((const f32x4*)(res + (size_t)row * DM) + lane + 64 * j);
        if constexpr (HAS_BR) {
            f32x4 b[4]; float ss = 0.f;
#pragma unroll
            for (int j = 0; j < 4; ++j) { const u32x2 w = *((const u32x2*)(br + (size_t)row * DM) + lane + 64 * j);
                b[j][0] = bf_lo(w.x); b[j][1] = bf_hi(w.x); b[j][2] = bf_lo(w.y); b[j][3] = bf_hi(w.y);
                ss += (b[j][0] * b[j][0] + b[j][1] * b[j][1]) + (b[j][2] * b[j][2] + b[j][3] * b[j][3]); }
            const float rstd = coef * __builtin_amdgcn_rsqf(wave_sum(ss) * (1.0f / DM) + EPS);
#pragma unroll
            for (int j = 0; j < 4; ++j) { const f32x4 g = *((const f32x4*)gbr + lane + 64 * j); v[j] = v[j] + b[j] * g * rstd; }
        }
        if constexpr (WRITE_RES) {
#pragma unroll
            for (int j = 0; j < 4; ++j) *((f32x4*)(outres + (size_t)row * DM) + lane + 64 * j) = v[j];
        }
        if constexpr (WRITE_NORM) {
            float ss = 0.f;
#pragma unroll
            for (int j = 0; j < 4; ++j) ss += (v[j][0] * v[j][0] + v[j][1] * v[j][1]) + (v[j][2] * v[j][2] + v[j][3] * v[j][3]);
            const float rstd = __builtin_amdgcn_rsqf(wave_sum(ss) * (1.0f / DM) + EPS);
            f32x4 hn[4];
#pragma unroll
            for (int j = 0; j < 4; ++j) { const f32x4 g = *((const f32x4*)gn + lane + 64 * j); hn[j] = v[j] * g * rstd;
                u32x2 w; w.x = pk2(hn[j][0], hn[j][1]); w.y = pk2(hn[j][2], hn[j][3]); *((u32x2*)(outn + (size_t)row * DM) + lane + 64 * j) = w; }
            if constexpr (DO_IF) {
                f32x4 a0 = {0.f, 0.f, 0.f, 0.f}, a1 = {0.f, 0.f, 0.f, 0.f};
#pragma unroll
                for (int j = 0; j < 4; ++j)
#pragma unroll
                    for (int e = 0; e < 4; ++e) { const f32x4 w0 = wif[((j * 4 + e) * 2 + 0) * 64 + lane], w1 = wif[((j * 4 + e) * 2 + 1) * 64 + lane];
                        a0 = a0 + w0 * hn[j][e]; a1 = a1 + w1 * hn[j][e]; }
                float r[8];
#pragma unroll
                for (int c = 0; c < 4; ++c) { r[c] = wave_sum(a0[c]); r[4 + c] = wave_sum(a1[c]); }
                if (lane == 0) { *(f32x4*)(IF + (size_t)row * 8) = (f32x4){r[0], r[1], r[2], r[3]}; *(f32x4*)(IF + (size_t)row * 8 + 4) = (f32x4){r[4], r[5], r[6], r[7]}; }
            }
        }
    }
}

__device__ __forceinline__ void attn_item(LAS unsigned char* lds, bf16_t* Qb, const bf16_t* Kb, const bf16_t* Vb, float* LSE, int it, int tid, int wave, int lane) {
    const int g = it >> 9, rem = it & 511, b = rem >> 6, slot = (rem >> 4) & 3, x = rem & 15;
    int dil, r, blk;
    if (g == 0) { dil = 1; r = 0; blk = x; } else if (g == 1) { dil = 4; r = x >> 2; blk = x & 3; } else { dil = 16; r = x; blk = 0; }
    const int q0 = blk * 128, cb = g * 512 + slot * 128;
    const int fr = lane & 15, fq = lane >> 4;
    LAS unsigned char* KS = lds; LAS unsigned char* VS = lds + 65536;
    {
        u32x4 kv[8], vv[8];
#pragma unroll
        for (int i = 0; i < 8; ++i) {
            const int id = tid + 512 * i, row = id >> 4, ch = id & 15, kn = q0 - 128 + row, knc = kn < 0 ? 0 : kn;
            const size_t off = (size_t)(b * SEQ + knc * dil + r) * 1536 + cb + ch * 8; kv[i] = *(const u32x4*)(Kb + off); vv[i] = *(const u32x4*)(Vb + off);
        }
#pragma unroll
        for (int i = 0; i < 8; ++i) {
            const int id = tid + 512 * i, row = id >> 4, ch = id & 15, kn = q0 - 128 + row;
            const u32x4 z = {0u, 0u, 0u, 0u};
            *(LAS u32x4*)(KS + row * 256 + ((ch ^ (row & 15)) << 4)) = kn < 0 ? z : kv[i];
            *(LAS u32x4*)(VS + row * 256 + ((ch ^ ((row & 7) << 1)) << 4)) = kn < 0 ? z : vv[i];
        }
    }
    const int qn = q0 + 16 * wave + fr; const size_t qrow = (size_t)(b * SEQ + qn * dil + r);
    bf16x8 qf[4];
#pragma unroll
    for (int ks = 0; ks < 4; ++ks) qf[ks] = *(const bf16x8*)(Qb + qrow * 1536 + cb + 32 * ks + 8 * fq);
    __syncthreads();
    f32x4 sa[9];
#pragma unroll
    for (int j = 0; j < 9; ++j) {
        const int krow = 16 * (wave + j) + fr;
        f32x4 a = {0.f, 0.f, 0.f, 0.f};
#pragma unroll
        for (int ks = 0; ks < 4; ++ks) {
            const bf16x8 kf = *(const LAS bf16x8*)(KS + krow * 256 + (((4 * ks + fq) ^ (krow & 15)) << 4));
            a = MFMA16(kf, qf[ks], a);
        }
        sa[j] = a;
    }
    const int kmin = 128 - q0;
    float mx = -INFINITY;
#pragma unroll
    for (int j = 0; j < 9; ++j)
#pragma unroll
        for (int i = 0; i < 4; ++i) { const int rel = 16 * j + 4 * fq + i - fr, kidx = 16 * (wave + j) + 4 * fq + i;
            const bool ok = (rel >= 0) && (rel <= 128) && (kidx >= kmin);
            sa[j][i] = ok ? sa[j][i] : -INFINITY; mx = fmaxf(mx, sa[j][i]); }
    mx = fmaxf(mx, __shfl_xor(mx, 16)); mx = fmaxf(mx, __shfl_xor(mx, 32));
    float l = 0.f;
#pragma unroll
    for (int j = 0; j < 9; ++j)
#pragma unroll
        for (int i = 0; i < 4; ++i) { const float p = __builtin_amdgcn_exp2f(sa[j][i] - mx); sa[j][i] = p; l += p; }
    l += __shfl_xor(l, 16); l += __shfl_xor(l, 32);
    f32x4 oa[8];
#pragma unroll
    for (int dt = 0; dt < 8; ++dt) oa[dt] = (f32x4){0.f, 0.f, 0.f, 0.f};
    const int tq = fr >> 2, tp = fr & 3;
#pragma unroll
    for (int s2 = 0; s2 < 5; ++s2) {
        u32x4 pw;
        pw.x = pk2(sa[2 * s2][0], sa[2 * s2][1]); pw.y = pk2(sa[2 * s2][2], sa[2 * s2][3]);
        if (s2 < 4) { pw.z = pk2(sa[2 * s2 + 1][0], sa[2 * s2 + 1][1]); pw.w = pk2(sa[2 * s2 + 1][2], sa[2 * s2 + 1][3]); } else { pw.z = 0u; pw.w = 0u; }
        const bf16x8 pf = __builtin_bit_cast(bf16x8, pw);
        int ta = wave + 2 * s2, tb = wave + 2 * s2 + 1; if (tb > 15) tb = 15;
        const int ra = 16 * ta + 4 * fq + tq, rb = 16 * tb + 4 * fq + tq;
#pragma unroll
        for (int dt = 0; dt < 8; ++dt) {
            const int g8 = 4 * dt + tp;
            const s16x4 va = vtr(VS + ra * 256 + ((g8 ^ ((ra & 7) << 2)) << 3));
            const s16x4 vb = vtr(VS + rb * 256 + ((g8 ^ ((rb & 7) << 2)) << 3));
            oa[dt] = MFMA16(cat8(va, vb), pf, oa[dt]);
        }
    }
    const float inv = 1.0f / l;
#pragma unroll
    for (int dt = 0; dt < 8; ++dt) { u32x2 w; w.x = pk2(oa[dt][0] * inv, oa[dt][1] * inv); w.y = pk2(oa[dt][2] * inv, oa[dt][3] * inv);
        *(u32x2*)(Qb + qrow * 1536 + cb + 16 * dt + 4 * fq) = w; }
    if (fq == 0) LSE[qrow * 12 + g * 4 + slot] = (mx + __builtin_amdgcn_logf(l)) * 0.6931471805599453f;
    __syncthreads();
}

constexpr int ML_QS = 0, ML_KS = 33792, ML_CB = 67584, ML_VE = 92928, ML_AV = 99072, ML_WW = 105216, ML_NUM = 114432, ML_SC = 127744;
constexpr int ML_P = 528;
__device__ __forceinline__ float scan_sum(float v, int lane) {
#pragma unroll
    for (int o = 1; o < 64; o <<= 1) { const float t = __shfl_up(v, o); if (lane >= o) v += t; }
    return v;
}
__device__ __forceinline__ float scan_max(float v, int lane) {
#pragma unroll
    for (int o = 1; o < 64; o <<= 1) { const float t = __shfl_up(v, o); if (lane >= o) v = fmaxf(v, t); }
    return v;
}
struct ConvHalo { u32x4 h0, h1, h2; };
__device__ __forceinline__ void bf8_to_f(const u32x4 w, float* d) { d[0] = bf_lo(w.x); d[1] = bf_hi(w.x); d[2] = bf_lo(w.y); d[3] = bf_hi(w.y); d[4] = bf_lo(w.z); d[5] = bf_hi(w.z); d[6] = bf_lo(w.w); d[7] = bf_hi(w.w); }
__device__ __forceinline__ void conv_halo(const bf16_t* QKMV, int gid, ConvHalo& H) {
    const int cg = gid & 255, rest = gid >> 8, b = rest >> 6, t0 = (rest & 63) * 32;
    const bf16_t* base = QKMV + (size_t)(b * SEQ) * 3072 + cg * 8;
    H.h0 = (u32x4){0u, 0u, 0u, 0u}; H.h1 = H.h0; H.h2 = H.h0;
    if (t0 > 0) { H.h0 = *(const u32x4*)(base + (size_t)(t0 - 3) * 3072); H.h1 = *(const u32x4*)(base + (size_t)(t0 - 2) * 3072); H.h2 = *(const u32x4*)(base + (size_t)(t0 - 1) * 3072); }
}
__device__ __forceinline__ void conv_run(bf16_t* QKMV, const float* conv_w, const float* conv_b, int gid, const ConvHalo& H) {
    const int cg = gid & 255, rest = gid >> 8, b = rest >> 6, t0 = (rest & 63) * 32;
    bf16_t* base = QKMV + (size_t)(b * SEQ) * 3072 + cg * 8;
    float cw[4][8], cbv[8];
#pragma unroll
    for (int j = 0; j < 4; ++j) { const f32x4 a = *(const f32x4*)(conv_w + j * 2048 + cg * 8), c = *(const f32x4*)(conv_w + j * 2048 + cg * 8 + 4);
        cw[j][0] = a[0]; cw[j][1] = a[1]; cw[j][2] = a[2]; cw[j][3] = a[3]; cw[j][4] = c[0]; cw[j][5] = c[1]; cw[j][6] = c[2]; cw[j][7] = c[3]; }
    { const f32x4 a = *(const f32x4*)(conv_b + cg * 8), c = *(const f32x4*)(conv_b + cg * 8 + 4);
        cbv[0] = a[0]; cbv[1] = a[1]; cbv[2] = a[2]; cbv[3] = a[3]; cbv[4] = c[0]; cbv[5] = c[1]; cbv[6] = c[2]; cbv[7] = c[3]; }
    const float kscale = (cg < 128) ? 1.0f : 0.0625f;
    float x0[8], x1[8], x2[8];
    bf8_to_f(H.h0, x0); bf8_to_f(H.h1, x1); bf8_to_f(H.h2, x2);
    for (int tb = 0; tb < 32; tb += 8) {
        u32x4 raw[8];
#pragma unroll
        for (int r = 0; r < 8; ++r) raw[r] = *(const u32x4*)(base + (size_t)(t0 + tb + r) * 3072);
#pragma unroll
        for (int r = 0; r < 8; ++r) {
            float x3[8], o[8]; bf8_to_f(raw[r], x3);
#pragma unroll
            for (int e = 0; e < 8; ++e) { const float sv = cbv[e] + cw[0][e] * x0[e] + cw[1][e] * x1[e] + cw[2][e] * x2[e] + cw[3][e] * x3[e];
                o[e] = sv * __builtin_amdgcn_rcpf(1.0f + __expf(-sv)) * kscale; x0[e] = x1[e]; x1[e] = x2[e]; x2[e] = x3[e]; }
            u32x4 w; w.x = pk2(o[0], o[1]); w.y = pk2(o[2], o[3]); w.z = pk2(o[4], o[5]); w.w = pk2(o[6], o[7]);
            *(u32x4*)(base + (size_t)(t0 + tb + r) * 3072) = w;
        }
    }
}

__device__ __forceinline__ void gates_prepass(LAS unsigned char* lds, const float* IF, const float* i_bias, const float* f_bias, float* GT, int bh, int tid, int wave, int lane) {
    const int b = bh >> 2, h = bh & 3;
    LAS float* BT = (LAS float*)lds; LAS float* IB = BT + 2048; LAS float* CM = IB + 2048; LAS float* BL = CM + 2048; LAS float* GM = BL + 32; LAS float* MS = GM + 32;
    const float ib_h = i_bias[h], fb_h = f_bias[h];
    for (int c = wave; c < 32; c += 8) {
        const size_t row = (size_t)b * SEQ + 64 * c + lane;
        const float ipre = IF[row * 8 + h] + ib_h, fpre = IF[row * 8 + 4 + h] + fb_h;
        const float lf = fminf(fpre, 0.f) - log1pf(__expf(-fabsf(fpre)));
        const float bt = scan_sum(lf, lane), ib = ipre - bt, cm = scan_max(ib, lane), bl = __shfl(bt, 63), gm = wave_max(bl + ib);
        BT[64 * c + lane] = bt; IB[64 * c + lane] = ib; CM[64 * c + lane] = cm;
        if (lane == 0) { BL[c] = bl; GM[c] = gm; }
    }
    __syncthreads();
    if (tid == 0) { float m = 0.f; MS[0] = 0.f; for (int c = 0; c < 32; ++c) { m = fmaxf(BL[c] + m, GM[c]); MS[c + 1] = m; } }
    __syncthreads();
    for (int c = wave; c < 32; c += 8) {
        const float bt = BT[64 * c + lane], ib = IB[64 * c + lane], cm = CM[64 * c + lane], bl = BL[c], mc = MS[c], mn = MS[c + 1];
        const float mt = bt + fmaxf(mc, cm);
        float* g = GT + ((size_t)bh * 32 + c) * 384;
        g[lane] = ib; g[64 + lane] = bt - mt; g[128 + lane] = __expf(bt + mc - mt); g[192 + lane] = __expf(-mt); g[256 + lane] = __expf(bl + ib - mn); g[320 + lane] = __expf(bl + mc - mn);
    }
    __syncthreads();
}

__device__ __forceinline__ void mlstm_item(LAS unsigned char* lds, const bf16_t* QKMV, const float* GT, bf16_t* HPRE, int it, int tid, int wave, int lane) {
    const int b = it >> 5, h = (it >> 3) & 3, sl = it & 7;
    const int fr = lane & 15, fq = lane >> 4, tq = fr >> 2, tp = fr & 3;
    LAS float* SC = (LAS float*)(lds + ML_SC);
    for (int i = tid; i < 25344 / 4; i += 512) ((LAS unsigned*)(lds + ML_CB))[i] = 0u;
    const int cch = (lane < 32 ? 0 : 1024) + h * 256 + (lane & 31) * 8;
    f32x4 cacc[2][3];
#pragma unroll
    for (int a = 0; a < 2; ++a)
#pragma unroll
        for (int v = 0; v < 3; ++v) cacc[a][v] = (f32x4){0.f, 0.f, 0.f, 0.f};
    const size_t rowb = (size_t)b * SEQ;
    const float* gt = GT + (size_t)(b * 4 + h) * 32 * 384;
    const int tg = wave;
    u32x4 xraw[8]; u32x4 vraw = {0u, 0u, 0u, 0u}; float gpre = 0.f;
#define ML_PREFETCH(c_) do { const int t0_ = 64 * (c_); \
        _Pragma("unroll") for (int rr = 0; rr < 8; ++rr) xraw[rr] = *(const u32x4*)(QKMV + (rowb + t0_ + 8 * tg + rr) * 3072 + cch); \
        if (wave < 4) vraw = *(const u32x4*)(QKMV + (rowb + t0_ + (tid >> 2)) * 3072 + 2048 + h * 256 + sl * 32 + (tid & 3) * 8); \
        if (tid < 384) gpre = gt[(c_) * 384 + tid]; } while (0)
    ML_PREFETCH(0);
    for (int c = 0; c < 32; ++c) {
        const int t0 = 64 * c;
        {
            LAS unsigned char* dst = lds + (lane < 32 ? ML_QS : ML_KS) + (lane & 31) * 16;
#pragma unroll
            for (int tt = 0; tt < 8; ++tt) *(LAS u32x4*)(dst + (8 * tg + tt) * ML_P) = xraw[tt];
        }
        if (wave < 4) { *(LAS u32x4*)(lds + ML_VE + (tid >> 2) * 96 + (tid & 3) * 16) = vraw; }
        else if (wave == 4) { *(LAS u32x4*)(lds + ML_VE + lane * 96 + 64) = (u32x4){0x3f80u, 0u, 0u, 0u}; *(LAS u32x4*)(lds + ML_VE + lane * 96 + 80) = (u32x4){0u, 0u, 0u, 0u}; }
        if (tid < 384) SC[tid] = gpre;
#if !defined(MLV) || !(MLV & 1)
        for (int i = tid; i < 64 * 52; i += 512) ((LAS float*)(lds + ML_NUM))[i] = 0.f;
#endif
        if (c + 1 < 32) ML_PREFETCH(c + 1);
        __syncthreads();
        if (wave < 4) {
            const int t = tid >> 2, c8 = tid & 3; const float at = SC[256 + t];
            const u32x4 w = *(const LAS u32x4*)(lds + ML_VE + t * 96 + c8 * 16);
            u32x4 o; o.x = pk2(bf_lo(w.x) * at, bf_hi(w.x) * at); o.y = pk2(bf_lo(w.y) * at, bf_hi(w.y) * at); o.z = pk2(bf_lo(w.z) * at, bf_hi(w.z) * at); o.w = pk2(bf_lo(w.w) * at, bf_hi(w.w) * at);
            *(LAS u32x4*)(lds + ML_AV + t * 96 + c8 * 16) = o;
        } else if (wave == 4) {
            *(LAS u32x4*)(lds + ML_AV + lane * 96 + 64) = (u32x4){f2bf(SC[256 + lane]), 0u, 0u, 0u}; *(LAS u32x4*)(lds + ML_AV + lane * 96 + 80) = (u32x4){0u, 0u, 0u, 0u};
        }
        {
            const int tt = wave >> 1;
#pragma unroll
            for (int u = 0; u < 2; ++u) {
                const int st = 2 * (wave & 1) + u;
                f32x4 a = {0.f, 0.f, 0.f, 0.f};
                if (st <= tt) {
#pragma unroll
                    for (int ks = 0; ks < 8; ++ks) {
                        const bf16x8 kf = *(const LAS bf16x8*)(lds + ML_KS + (16 * st + fr) * ML_P + 64 * ks + 16 * fq);
                        const bf16x8 qf = *(const LAS bf16x8*)(lds + ML_QS + (16 * tt + fr) * ML_P + 64 * ks + 16 * fq);
                        a = MFMA16(kf, qf, a);
                    }
                }
                const int t = 16 * tt + fr; const float bmt = SC[64 + t];
                float w[4];
#pragma unroll
                for (int i = 0; i < 4; ++i) { const int s2 = 16 * st + 4 * fq + i; w[i] = (s2 <= t) ? __expf(bmt + SC[s2]) * a[i] : 0.f; }
                u32x2 o; o.x = pk2(w[0], w[1]); o.y = pk2(w[2], w[3]);
                *(LAS u32x2*)(lds + ML_WW + t * 144 + (16 * st + 4 * fq) * 2) = o;
            }
        }
        __syncthreads();
#if defined(MLV) && (MLV & 1)
        for (int tile = wave; tile < 12; tile += 8) {
            const int tt = tile & 3, vt = tile >> 2;
            f32x4 aw = {0.f, 0.f, 0.f, 0.f}, ac = {0.f, 0.f, 0.f, 0.f};
#pragma unroll
            for (int k2 = 0; k2 < 2; ++k2) {
                const bf16x8 wf = *(const LAS bf16x8*)(lds + ML_WW + (16 * tt + fr) * 144 + 64 * k2 + 16 * fq);
                const LAS unsigned char* vp = lds + ML_VE + (32 * k2 + 8 * fq + tq) * 96 + (16 * vt + 4 * tp) * 2;
                aw = MFMA16(wf, cat8(vtr(vp), vtr(vp + 4 * 96)), aw);
            }
#pragma unroll
            for (int ks = 0; ks < 8; ++ks) {
                const bf16x8 qf = *(const LAS bf16x8*)(lds + ML_QS + (16 * tt + fr) * ML_P + 64 * ks + 16 * fq);
                const bf16x8 cf = *(const LAS bf16x8*)(lds + ML_CB + (16 * vt + fr) * ML_P + 64 * ks + 16 * fq);
                ac = MFMA16(qf, cf, ac);
            }
#pragma unroll
            for (int i = 0; i < 4; ++i) { const int t = 16 * tt + 4 * fq + i; ((LAS float*)(lds + ML_NUM))[t * 52 + 16 * vt + fr] = aw[i] + SC[128 + t] * ac[i]; }
        }
#else
        {
            const int tt = wave & 3, hf = wave >> 2;
            f32x4 aw[3], ac[3];
#pragma unroll
            for (int vt = 0; vt < 3; ++vt) { aw[vt] = (f32x4){0.f, 0.f, 0.f, 0.f}; ac[vt] = (f32x4){0.f, 0.f, 0.f, 0.f}; }
            {
                const bf16x8 wf = *(const LAS bf16x8*)(lds + ML_WW + (16 * tt + fr) * 144 + 64 * hf + 16 * fq);
#pragma unroll
                for (int vt = 0; vt < 3; ++vt) {
                    const LAS unsigned char* vp = lds + ML_VE + (32 * hf + 8 * fq + tq) * 96 + (16 * vt + 4 * tp) * 2;
                    aw[vt] = MFMA16(wf, cat8(vtr(vp), vtr(vp + 4 * 96)), aw[vt]);
                }
            }
#pragma unroll
            for (int k4 = 0; k4 < 4; ++k4) {
                const int ks = 4 * hf + k4;
                const bf16x8 qf = *(const LAS bf16x8*)(lds + ML_QS + (16 * tt + fr) * ML_P + 64 * ks + 16 * fq);
#pragma unroll
                for (int vt = 0; vt < 3; ++vt) {
                    const bf16x8 cf = *(const LAS bf16x8*)(lds + ML_CB + (16 * vt + fr) * ML_P + 64 * ks + 16 * fq);
                    ac[vt] = MFMA16(qf, cf, ac[vt]);
                }
            }
#pragma unroll
            for (int i = 0; i < 4; ++i) { const int t = 16 * tt + 4 * fq + i; const float in = SC[128 + t];
#pragma unroll
                for (int vt = 0; vt < 3; ++vt) atomicAdd((float*)((LAS float*)(lds + ML_NUM) + t * 52 + 16 * vt + fr), aw[vt][i] + in * ac[vt][i]); }
        }
#endif
        __syncthreads();
        {
            const int t = tid >> 3, v4 = (tid & 7) * 4;
            const LAS float* nr = (const LAS float*)(lds + ML_NUM) + t * 52;
            const float den = fmaxf(fabsf(nr[32]), SC[192 + t]); const float inv = 1.0f / den;
            const f32x4 nv = *(const LAS f32x4*)(nr + v4);
            u32x2 o; o.x = pk2(nv[0] * inv, nv[1] * inv); o.y = pk2(nv[2] * inv, nv[3] * inv);
            *(u32x2*)(HPRE + (rowb + t0 + t) * 1024 + h * 256 + sl * 32 + v4) = o;
        }
        {
            const float decay = SC[320];
#pragma unroll
            for (int a = 0; a < 2; ++a) {
                const int kt = 2 * wave + a;
                bf16x8 kf[2];
#pragma unroll
                for (int k2 = 0; k2 < 2; ++k2) {
                    const LAS unsigned char* kp = lds + ML_KS + (32 * k2 + 8 * fq + tq) * ML_P + (16 * kt + 4 * tp) * 2;
                    kf[k2] = cat8(vtr(kp), vtr(kp + 4 * ML_P));
                }
#pragma unroll
                for (int vt = 0; vt < 3; ++vt) {
                    f32x4 acc = cacc[a][vt] * decay;
#pragma unroll
                    for (int k2 = 0; k2 < 2; ++k2) {
                        const LAS unsigned char* vp = lds + ML_AV + (32 * k2 + 8 * fq + tq) * 96 + (16 * vt + 4 * tp) * 2;
                        acc = MFMA16(kf[k2], cat8(vtr(vp), vtr(vp + 4 * 96)), acc);
                    }
                    cacc[a][vt] = acc;
                    u32x2 o; o.x = pk2(acc[0], acc[1]); o.y = pk2(acc[2], acc[3]);
                    *(LAS u32x2*)(lds + ML_CB + (16 * vt + fr) * ML_P + (16 * kt + 4 * fq) * 2) = o;
                }
            }
        }
        __syncthreads();
    }
#undef ML_PREFETCH
}

#define XB_TMO      128
#define XB_XCNT(j)  (256  + 64 * (j))
#define XB_XSUB(j)  (1280 + 64 * (j))
#define XB_XGEN(j)  (2304 + 64 * (j))
#define XB_TOP      3328
#define XB_TOPGEN   3392
#define XCD_BAR_WORDS 3456
#define XB_SPIN_CAP (1u << 18)

__device__ __forceinline__ unsigned xb_ld(unsigned* p)              { return __hip_atomic_load(p, __ATOMIC_RELAXED, __HIP_MEMORY_SCOPE_AGENT); }
__device__ __forceinline__ unsigned xb_add(unsigned* p, unsigned v) { return __hip_atomic_fetch_add(p, v, __ATOMIC_RELAXED, __HIP_MEMORY_SCOPE_AGENT); }
__device__ __forceinline__ unsigned xb_xcc_id() { return (unsigned)__builtin_amdgcn_s_getreg((3 << 11) | 20) & 0xFu; }
#define XB_SPIN(cond, bar) do { unsigned _sp = 0; while (cond) { __builtin_amdgcn_s_sleep(1); \
    if ((++_sp & 255u) == 0u) { if (xb_ld(&(bar)[XB_TMO])) break; if (_sp > XB_SPIN_CAP) { atomicAdd(&(bar)[XB_TMO], 1u); break; } } } } while (0)

struct XcdBarrier {
    unsigned* bar; unsigned x;
    volatile LAS unsigned* st;
};

__device__ __forceinline__ XcdBarrier xcd_barrier_post(unsigned* bar, volatile LAS unsigned* st) {
    XcdBarrier b; b.bar = bar; b.x = xb_xcc_id(); b.st = st;
    if (threadIdx.x == 0) (void)xb_add(&bar[XB_XCNT(b.x)], 1u);
    return b;
}
__device__ __forceinline__ void xcd_barrier_complete(unsigned* bar, unsigned x, unsigned& nloc, unsigned& nx) {
    const unsigned G = gridDim.x * gridDim.y * gridDim.z;
    unsigned sum, cnt, mine, sp = 0u;
    for (;;) {
        sum = 0u; cnt = 0u; mine = 0u;
#pragma unroll
        for (unsigned j = 0; j < 16; ++j) { const unsigned c = xb_ld(&bar[XB_XCNT(j)]); sum += c; cnt += (c > 0u) ? 1u : 0u; mine = (j == x) ? c : mine; }
        if (sum == G) break;
        __builtin_amdgcn_s_sleep(1);
        if ((++sp & 255u) == 0u) { if (xb_ld(&bar[XB_TMO])) break; if (sp > XB_SPIN_CAP) { atomicAdd(&bar[XB_TMO], 1u); break; } }
    }
    nloc = mine > 0u ? mine : 1u; nx = cnt > 0u ? cnt : 1u;
}

__device__ __forceinline__ void xcd_barrier(const XcdBarrier& b) {
    asm volatile("s_waitcnt vmcnt(0)" ::: "memory");
    __syncthreads();
    if (threadIdx.x == 0) {
        unsigned* bar = b.bar;
        __builtin_amdgcn_s_waitcnt(0);
        unsigned nloc = b.st[0], nx = b.st[1];
        if (nloc == 0u) { xcd_barrier_complete(bar, b.x, nloc, nx); b.st[0] = nloc; b.st[1] = nx; }
        const unsigned old = xb_add(&bar[XB_XSUB(b.x)], 1u);
        const unsigned gen = old / nloc;
        if (old + 1u == (gen + 1u) * nloc) {
            __builtin_amdgcn_fence(__ATOMIC_RELEASE, "agent");
            asm volatile("s_waitcnt vmcnt(0)" ::: "memory");
            const unsigned og = xb_add(&bar[XB_TOP], 1u);
            const unsigned tg = og / nx;
            if (og + 1u == (tg + 1u) * nx) xb_add(&bar[XB_TOPGEN], 1u);
            else XB_SPIN(xb_ld(&bar[XB_TOPGEN]) == tg, bar);
            __builtin_amdgcn_fence(__ATOMIC_ACQUIRE, "agent");
            xb_add(&bar[XB_XGEN(b.x)], 1u);
            asm volatile("s_waitcnt vmcnt(0)" ::: "memory");
        } else {
            XB_SPIN(xb_ld(&bar[XB_XGEN(b.x)]) == gen, bar);
            __builtin_amdgcn_fence(__ATOMIC_ACQUIRE, "agent");
            asm volatile("s_waitcnt vmcnt(0)" ::: "memory");
        }
    }
    __syncthreads();
}

#define grid_seam() xcd_barrier(bar)

__global__ void __launch_bounds__(512, 2) hybrid_fwd(Args args) {
    extern __shared__ __attribute__((aligned(16))) unsigned char lds_raw[];
    LAS unsigned char* lds = (LAS unsigned char*)lds_raw;

    const int tid = threadIdx.x, lane = tid & 63, wave = __builtin_amdgcn_readfirstlane(tid >> 6);
    const int G = gridDim.x, bid = blockIdx.x;
    const int gw = bid * 8 + wave, ngw = G * 8;
    unsigned char* ws = args.ws;
    if (tid < 2) ((LAS unsigned*)(lds + RING_BYTES))[tid] = 0u;
    __syncthreads();
    cg::this_grid().sync();
    XcdBarrier bar = xcd_barrier_post((unsigned*)ws, (volatile LAS unsigned*)(lds + RING_BYTES));
    const float* x = args.in[0];
    float* X = args.out;
    bf16_t* WGU1 = (bf16_t*)(ws + WS_WGU1); bf16_t* WD1 = (bf16_t*)(ws + WS_WD1); bf16_t* WGU2 = (bf16_t*)(ws + WS_WGU2); bf16_t* WD2 = (bf16_t*)(ws + WS_WD2);
    bf16_t* WIN = (bf16_t*)(ws + WS_WIN); bf16_t* WA = (bf16_t*)(ws + WS_WA); bf16_t* WM = (bf16_t*)(ws + WS_WM); bf16_t* WO = (bf16_t*)(ws + WS_WO);
    bf16_t* H = (bf16_t*)(ws + WS_H); bf16_t* ACT = (bf16_t*)(ws + WS_ACT); bf16_t* F = (bf16_t*)(ws + WS_F);
    bf16_t* Qb = (bf16_t*)(ws + WS_Q); bf16_t* ATT = (bf16_t*)(ws + WS_ATT); bf16_t* QKMV = (bf16_t*)(ws + WS_QKMV); bf16_t* HPRE = (bf16_t*)(ws + WS_HPRE);
    bf16_t* OG = (bf16_t*)(ws + WS_OG); bf16_t* Y = (bf16_t*)(ws + WS_Y);
    float* IF = (float*)(ws + WS_IF); float* LSE = (float*)(ws + WS_LSE); float* ROPE = (float*)(ws + WS_ROPE); float* GT = (float*)(ws + WS_GT);

    {
        LAS float* scr = (LAS float*)(lds + wave * 16384);
        constexpr int I_G = 16 * 88, I_D = 44 * 32, I_INA = 16 * 272, I_INB = 16 * 64, I_A = 8 * 32, I_M = 16 * 32;
        constexpr int NIT = 6 * I_G + I_INA + I_INB + I_A + 2 * I_M;
        for (int it = gw; it < NIT; it += ngw) {
            int r = it;
            if (r < 4 * I_G) {
                const int w = r / I_G; r -= w * I_G; const int kb = r / 88, nb = r % 88;
                const float* src = args.in[w == 0 ? 2 : w == 1 ? 3 : w == 2 ? 18 : 19];
                tr_item(src, DFF, 32 * nb, 64 * kb, (w < 2) ? WGU1 : WGU2, 1024, 256 * (nb >> 2) + 32 * (nb & 3) + 128 * (w & 1), scr, lane); continue; }
            r -= 4 * I_G;
            if (r < 2 * I_D) {
                const int w = r / I_D; r -= w * I_D; const int kb = r / 32, nb = r % 32;
                tr_item(args.in[w == 0 ? 4 : 20], 1024, 32 * nb, 64 * kb, w == 0 ? WD1 : WD2, DFF, 32 * nb, scr, lane); continue; }
            r -= 2 * I_D;
            if (r < I_INA) { const int kb = r / 272, nb = r % 272; tr_item(args.in[7], INW, 32 * nb, 64 * kb, WIN, 1024, 32 * nb, scr, lane); continue; }
            r -= I_INA;
            if (r < I_INB) { const int kb = r / 64, nb = r % 64; tr_item(args.in[7], INW, 8712 + 32 * nb, 64 * kb, WIN, 1024, 8704 + 32 * nb, scr, lane); continue; }
            r -= I_INB;
            if (r < I_A) { const int kb = r / 32, nb = r % 32; tr_item(args.in[13], 1024, 32 * nb, 64 * kb, WA, 512, 32 * nb, scr, lane); continue; }
            r -= I_A;
            if (r < I_M) { const int kb = r / 32, nb = r % 32; tr_item(args.in[14], 1024, 32 * nb, 64 * kb, WM, 1024, 32 * nb, scr, lane); continue; }
            r -= I_M;
            { const int kb = r / 32, nb = r % 32; tr_item(args.in[15], 1024, 32 * nb, 64 * kb, WO, 1024, 32 * nb, scr, lane); }
        }
        for (int id = bid * 512 + tid; id < 2048 * 16; id += G * 512) {
            const int pos = id >> 4, i = id & 15;
            const float invf = powf(500000.0f, -((float)i * 2.0f / 32.0f));
            const float ang = (float)pos * invf;
            const double a = (double)ang; const double k = rint(a * 0.15915494309189535); const float rr = (float)(a - k * 6.283185307179586);
            ROPE[2 * id] = cosf(rr); ROPE[2 * id + 1] = sinf(rr);
        }
        rowpass<false, false, true, false>(gw, ngw, lane, x, nullptr, 0.f, nullptr, nullptr, args.in[1], H, nullptr, nullptr);
    }
#if defined(DUP) && (DUP & 2)
    grid_seam();
    {
        LAS float* scr = (LAS float*)(lds + wave * 16384);
        constexpr int I_G = 16 * 88, I_D = 44 * 32, I_INA = 16 * 272, I_INB = 16 * 64, I_A = 8 * 32, I_M = 16 * 32;
        constexpr int NIT = 6 * I_G + I_INA + I_INB + I_A + 2 * I_M;
        for (int it = gw; it < NIT; it += ngw) {
            int r = it;
            if (r < 4 * I_G) {
                const int w = r / I_G; r -= w * I_G; const int kb = r / 88, nb = r % 88;
                const float* src = args.in[w == 0 ? 2 : w == 1 ? 3 : w == 2 ? 18 : 19];
                tr_item(src, DFF, 32 * nb, 64 * kb, (w < 2) ? WGU1 : WGU2, 1024, 256 * (nb >> 2) + 32 * (nb & 3) + 128 * (w & 1), scr, lane); continue; }
            r -= 4 * I_G;
            if (r < 2 * I_D) {
                const int w = r / I_D; r -= w * I_D; const int kb = r / 32, nb = r % 32;
                tr_item(args.in[w == 0 ? 4 : 20], 1024, 32 * nb, 64 * kb, w == 0 ? WD1 : WD2, DFF, 32 * nb, scr, lane); continue; }
            r -= 2 * I_D;
            if (r < I_INA) { const int kb = r / 272, nb = r % 272; tr_item(args.in[7], INW, 32 * nb, 64 * kb, WIN, 1024, 32 * nb, scr, lane); continue; }
            r -= I_INA;
            if (r < I_INB) { const int kb = r / 64, nb = r % 64; tr_item(args.in[7], INW, 8712 + 32 * nb, 64 * kb, WIN, 1024, 8704 + 32 * nb, scr, lane); continue; }
            r -= I_INB;
            if (r < I_A) { const int kb = r / 32, nb = r % 32; tr_item(args.in[13], 1024, 32 * nb, 64 * kb, WA, 512, 32 * nb, scr, lane); continue; }
            r -= I_A;
            if (r < I_M) { const int kb = r / 32, nb = r % 32; tr_item(args.in[14], 1024, 32 * nb, 64 * kb, WM, 1024, 32 * nb, scr, lane); continue; }
            r -= I_M;
            { const int kb = r / 32, nb = r % 32; tr_item(args.in[15], 1024, 32 * nb, 64 * kb, WO, 1024, 32 * nb, scr, lane); }
        }
        for (int id = bid * 512 + tid; id < 2048 * 16; id += G * 512) {
            const int pos = id >> 4, i = id & 15;
            const float invf = powf(500000.0f, -((float)i * 2.0f / 32.0f));
            const float ang = (float)pos * invf;
            const double a = (double)ang; const double k = rint(a * 0.15915494309189535); const float rr = (float)(a - k * 6.283185307179586);
            ROPE[2 * id] = cosf(rr); ROPE[2 * id + 1] = sinf(rr);
        }
        rowpass<false, false, true, false>(gw, ngw, lane, x, nullptr, 0.f, nullptr, nullptr, args.in[1], H, nullptr, nullptr);
    }
#endif
    grid_seam();
#if defined(DUP) && (DUP & 4)
    grid_seam(); grid_seam(); grid_seam(); grid_seam(); grid_seam(); grid_seam(); grid_seam(); grid_seam(); grid_seam(); grid_seam();
#endif
    { pg8::Gemm g{H, WGU1, M, 5632, 1024}; pg8::StaticOrder S; S.init(M, 5632, G, bid); pg8::Epi<1> E{ACT, DFF, nullptr, 0, 0, nullptr, 1.f, 0};
      pg8::gemm_phase<pg8::Epi<1>, pg8::StaticOrder, true, true>(lds, g, S, E); }
#if defined(DUP) && (DUP & 8)
    grid_seam();
    { pg8::Gemm g{H, WGU1, M, 5632, 1024}; pg8::StaticOrder S; S.init(M, 5632, G, bid); pg8::Epi<1> E{ACT, DFF, nullptr, 0, 0, nullptr, 1.f, 0};
      pg8::gemm_phase<pg8::Epi<1>, pg8::StaticOrder, true, true>(lds, g, S, E); }
#endif
    grid_seam();
    { pg8::Gemm g{ACT, WD1, M, 1024, DFF}; pg8::StaticOrder S; S.init(M, 1024, G, bid); pg8::Epi<0> E{F, 1024, nullptr, 0, 0, nullptr, 1.f, 0};
      pg8::gemm_phase<pg8::Epi<0>, pg8::StaticOrder, true, true>(lds, g, S, E); }
    grid_seam();
    {
        LAS f32x4* wif = (LAS f32x4*)lds;
        const float* win = args.in[7];
        for (int i = tid; i < 32 * 64; i += 512) { const int ln = i & 63, q = i >> 6, half = q & 1, e = (q >> 1) & 3, j = q >> 3; const int k = 4 * ln + e + 256 * j;
            const float* p = win + (size_t)k * INW + 8704 + 4 * half; wif[i] = (f32x4){p[0], p[1], p[2], p[3]}; }
        __syncthreads();
        rowpass<true, true, true, true>(gw, ngw, lane, x, F, 0.5f, args.in[5], X, args.in[6], H, wif, IF);
        __syncthreads();
    }
    grid_seam();
#if !defined(VAR) || VAR != 1
    { pg8::Gemm g{H, WIN, M, 4608, 1024}; pg8::StaticOrder S; S.init(M, 4608, G, bid);
      pg8::Epi<3> E{Qb, 1536, nullptr, 0, 0, ROPE, 0.08838834764831845f * 1.4426950408889634f, (size_t)M * 1536};
      pg8::gemm_phase<pg8::Epi<3>, pg8::StaticOrder, true, true>(lds, g, S, E); }
#if defined(DUP) && (DUP & 16)
    grid_seam();
    { pg8::Gemm g{H, WIN, M, 4608, 1024}; pg8::StaticOrder S; S.init(M, 4608, G, bid);
      pg8::Epi<3> E{Qb, 1536, nullptr, 0, 0, ROPE, 0.08838834764831845f * 1.4426950408889634f, (size_t)M * 1536};
      pg8::gemm_phase<pg8::Epi<3>, pg8::StaticOrder, true, true>(lds, g, S, E); }
#endif
    grid_seam();
    for (int it = bid; it < 1536; it += G) attn_item(lds, Qb, Qb + (size_t)M * 1536, Qb + (size_t)2 * M * 1536, LSE, it, tid, wave, lane);
#if defined(DUP) && (DUP & 32)
    grid_seam();
    { pg8::Gemm g{H, WIN, M, 4608, 1024}; pg8::StaticOrder S; S.init(M, 4608, G, bid);
      pg8::Epi<3> E{Qb, 1536, nullptr, 0, 0, ROPE, 0.08838834764831845f * 1.4426950408889634f, (size_t)M * 1536};
      pg8::gemm_phase<pg8::Epi<3>, pg8::StaticOrder, true, true>(lds, g, S, E); }
    grid_seam();
    for (int it = bid; it < 1536; it += G) attn_item(lds, Qb, Qb + (size_t)M * 1536, Qb + (size_t)2 * M * 1536, LSE, it, tid, wave, lane);
#endif
    grid_seam();
    if (bid < 32) gates_prepass(lds, IF, args.in[10], args.in[11], GT, bid, tid, wave, lane);
    for (int row = gw; row < M; row += ngw) {
        const int slot = lane >> 4;
        const float l0 = LSE[(size_t)row * 12 + slot], l1 = LSE[(size_t)row * 12 + 4 + slot], l2 = LSE[(size_t)row * 12 + 8 + slot];
        const float mx = fmaxf(l0, fmaxf(l1, l2));
        float e0 = __expf(l0 - mx), e1 = __expf(l1 - mx), e2 = __expf(l2 - mx); const float inv = 1.0f / (e0 + e1 + e2); e0 *= inv; e1 *= inv; e2 *= inv;
        f32x4 a0, a1, b0, b1, c0, c1;
        pg8::load8(Qb + (size_t)row * 1536 + 8 * lane, a0, a1); pg8::load8(Qb + (size_t)row * 1536 + 512 + 8 * lane, b0, b1); pg8::load8(Qb + (size_t)row * 1536 + 1024 + 8 * lane, c0, c1);
        pg8::store8(ATT + (size_t)row * 512 + 8 * lane, a0 * e0 + b0 * e1 + c0 * e2, a1 * e0 + b1 * e1 + c1 * e2);
    }
    { pg8::Gemm g{H, WIN + (size_t)4608 * 1024, M, 3072, 1024}; pg8::StaticOrder S; S.init(M, 3072, G, bid); pg8::Epi<0> E{QKMV, 3072, nullptr, 0, 0, nullptr, 1.f, 0};
      pg8::gemm_phase<pg8::Epi<0>, pg8::StaticOrder, true, true>(lds, g, S, E); }
    grid_seam();
    { ConvHalo CH; conv_halo(QKMV, bid * 512 + tid, CH); grid_seam(); conv_run(QKMV, args.in[8], args.in[9], bid * 512 + tid, CH); }
    grid_seam();
#if defined(VAR) && VAR == 4
    for (int row = gw; row < M; row += ngw) { const u32x4 a = *(const u32x4*)(QKMV + (size_t)row * 3072 + 2048 + 16 * lane), b2 = *(const u32x4*)(QKMV + (size_t)row * 3072 + 2048 + 16 * lane + 8);
        *(u32x4*)(HPRE + (size_t)row * 1024 + 16 * lane) = a; *(u32x4*)(HPRE + (size_t)row * 1024 + 16 * lane + 8) = b2; }
#elif !defined(VAR) || VAR != 2
    for (int it = bid; it < 256; it += G) mlstm_item(lds, QKMV, GT, HPRE, it, tid, wave, lane);
#endif
#if defined(DUP) && (DUP & 1)
    grid_seam();
    for (int it = bid; it < 256; it += G) mlstm_item(lds, QKMV, GT, HPRE, it, tid, wave, lane);
#endif
    grid_seam();
    { pg8::Gemm g{H, WIN + (size_t)7680 * 1024, M, 3072, 1024}; pg8::StaticOrder S; S.init(M, 3072, G, bid); pg8::Epi<2> E{OG, 3072, nullptr, 0, 0, nullptr, 1.f, 0};
      pg8::gemm_phase<pg8::Epi<2>, pg8::StaticOrder, true, true>(lds, g, S, E); }
    grid_seam();
#if !defined(VAR) || VAR != 2
    {
        const float* hg = args.in[12];
        for (int row = gw; row < M; row += ngw) {
            bf16_t* hp = HPRE + (size_t)row * 1024 + 16 * lane;
            f32x4 v[4], o[4];
            pg8::load8(hp, v[0], v[1]); pg8::load8(hp + 8, v[2], v[3]);
            pg8::load8(OG + (size_t)row * 3072 + 16 * lane, o[0], o[1]); pg8::load8(OG + (size_t)row * 3072 + 16 * lane + 8, o[2], o[3]);
            float ss = 0.f;
#pragma unroll
            for (int j = 0; j < 4; ++j) ss += (v[j][0] * v[j][0] + v[j][1] * v[j][1]) + (v[j][2] * v[j][2] + v[j][3] * v[j][3]);
            ss += __shfl_xor(ss, 1); ss += __shfl_xor(ss, 2); ss += __shfl_xor(ss, 4); ss += __shfl_xor(ss, 8);
            const float rstd = __builtin_amdgcn_rsqf(ss * (1.0f / 256.0f) + EPS);
#pragma unroll
            for (int j = 0; j < 4; ++j) { const f32x4 gg = *(const f32x4*)(hg + 16 * lane + 4 * j); v[j] = v[j] * gg * o[j] * rstd; }
            pg8::store8(hp, v[0], v[1]); pg8::store8(hp + 8, v[2], v[3]);
        }
    }
#endif
    { pg8::Gemm g{ATT, WA, M, 1024, 512}; pg8::StaticOrder S; S.init(M, 1024, G, bid); pg8::Epi<4> E{H, 1024, OG, 3072, 1024, nullptr, 1.f, 0};
      pg8::gemm_phase<pg8::Epi<4>, pg8::StaticOrder, true, true>(lds, g, S, E); }
    grid_seam();
#if !defined(VAR) || VAR != 2
    { pg8::Gemm g{HPRE, WM, M, 1024, 1024}; pg8::StaticOrder S; S.init(M, 1024, G, bid); pg8::Epi<5> E{H, 1024, OG, 3072, 2048, nullptr, 1.f, 0};
      pg8::gemm_phase<pg8::Epi<5>, pg8::StaticOrder, true, true>(lds, g, S, E); }
#endif
    grid_seam();
    { pg8::Gemm g{H, WO, M, 1024, 1024}; pg8::StaticOrder S; S.init(M, 1024, G, bid); pg8::Epi<0> E{Y, 1024, nullptr, 0, 0, nullptr, 1.f, 0};
      pg8::gemm_phase<pg8::Epi<0>, pg8::StaticOrder, true, true>(lds, g, S, E); }
    grid_seam();
#endif
#if defined(VAR) && VAR == 1
    rowpass<false, false, true, false>(gw, ngw, lane, X, nullptr, 0.f, nullptr, nullptr, args.in[17], H, nullptr, nullptr);
#else
    rowpass<true, true, true, false>(gw, ngw, lane, X, Y, 1.0f, args.in[16], X, args.in[17], H, nullptr, nullptr);
#endif
    grid_seam();
    { pg8::Gemm g{H, WGU2, M, 5632, 1024}; pg8::StaticOrder S; S.init(M, 5632, G, bid); pg8::Epi<1> E{ACT, DFF, nullptr, 0, 0, nullptr, 1.f, 0};
      pg8::gemm_phase<pg8::Epi<1>, pg8::StaticOrder, true, true>(lds, g, S, E); }
    grid_seam();
    { pg8::Gemm g{ACT, WD2, M, 1024, DFF}; pg8::StaticOrder S; S.init(M, 1024, G, bid); pg8::Epi<0> E{F, 1024, nullptr, 0, 0, nullptr, 1.f, 0};
      pg8::gemm_phase<pg8::Epi<0>, pg8::StaticOrder, true, true>(lds, g, S, E); }
    grid_seam();
    rowpass<true, true, false, false>(gw, ngw, lane, X, F, 0.5f, args.in[21], X, nullptr, nullptr, nullptr, nullptr);
}

extern "C" void kernel_launch(void* const* d_in, const int* in_sizes, int n_in, void* d_out, int out_size, void* d_ws, size_t ws_size, hipStream_t stream) {
    static int grid = 0;
    if (grid == 0) {
        if (n_in != 22 || out_size != M * DM || ws_size < WS_END) { fprintf(stderr, "kernel_launch: unexpected shapes (n_in %d out %d ws %zu)\n", n_in, out_size, ws_size); grid = -1; return; }
        int dev = 0, cus = 0, per_cu = 0;
        hipGetDevice(&dev);
        hipDeviceGetAttribute(&cus, hipDeviceAttributeMultiprocessorCount, dev);
        if (hipFuncSetAttribute((const void*)hybrid_fwd, hipFuncAttributeMaxDynamicSharedMemorySize, LDS_BYTES) != hipSuccess) { fprintf(stderr, "kernel_launch: hipFuncSetAttribute failed\n"); grid = -1; return; }
        if (hipOccupancyMaxActiveBlocksPerMultiprocessor(&per_cu, (const void*)hybrid_fwd, 512, LDS_BYTES) != hipSuccess || per_cu < 1) { fprintf(stderr, "kernel_launch: occupancy query says %d\n", per_cu); per_cu = 1; }
        (void)hipGetLastError();
        grid = cus;
        if (grid > 256) grid = 256;
    }
    if (grid < 0) return;
    Args a{};
    for (int i = 0; i < 22; ++i) a.in[i] = (const float*)d_in[i];
    a.out = (float*)d_out; a.ws = (unsigned char*)d_ws;
    if (hipMemsetAsync(d_ws, 0, 16384, stream) != hipSuccess) { fprintf(stderr, "memset failed\n"); return; }
    void* kargs[] = {&a};
    hipError_t e = hipLaunchCooperativeKernel((const void*)hybrid_fwd, dim3(grid), dim3(512), kargs, LDS_BYTES, stream);
    if (e != hipSuccess) fprintf(stderr, "cooperative launch failed: %s (grid %d)\n", hipGetErrorString(e), grid);
}
```

```cpp
#define MLV 1
#include <hip/hip_runtime.h>
#include <hip/hip_cooperative_groups.h>
#include <cstdio>
#include <cstdint>
namespace cg = cooperative_groups;
namespace pg8 {
#define PG8_LAS __attribute__((address_space(3)))
typedef unsigned short bf16_t;
typedef short bf16x8 __attribute__((ext_vector_type(8)));
typedef float f32x4 __attribute__((ext_vector_type(4)));
typedef unsigned u32x4 __attribute__((ext_vector_type(4)));
constexpr int BM = 256, BK = 64, HALF = 128, HTB = HALF * BK * 2  , STAGE_BYTES = 8 * HTB, NXCD = 8, WGM = 8;

__host__ __device__ __forceinline__ int lds_byte(int r, int c) { const int st = (r >> 4) * 2 + (c >> 5), rr = r & 15, cc = c & 31, ob = rr * 64 + cc * 2; return st * 1024 + (ob ^ (((ob >> 9) & 1) << 5)); }
__host__ __device__ __forceinline__ void stage_rc(int b, int& R, int& C) { const int st = b / 1024, sb = b % 1024, swz = sb ^ (((sb >> 9) & 1) << 5); R = (st >> 1) * 16 + swz / 64; C = (st & 1) * 32 + (swz % 64) / 2; }
__host__ __device__ __forceinline__ int perm32(int rho) { const int n = rho >> 4, i = rho & 15; return 8 * (i >> 2) + 4 * n + (i & 3); }

struct Unit { int pm, pn; };
struct Gemm { const bf16_t* A; const bf16_t* Bt; int M, N, K; };

struct StaticOrder {
    int nM, nN, nwg, G, c;
    __host__ __device__ void init(int M, int N, int G_, int c_) { nM = M / BM; nN = N / BM; nwg = nM * nN; G = G_; c = c_; }
    __host__ __device__ bool next(int i, Unit& u) const {
        const long L = (long)i * G + c; if (L >= nwg) return false;
        int wgid = (int)L; { const int q = nwg / NXCD, r = nwg % NXCD, xcd = wgid % NXCD, off = wgid / NXCD; wgid = (xcd < r ? xcd * (q + 1) : r * (q + 1) + (xcd - r) * q) + off; }
        const int nig = WGM * nN, gid = wgid / nig, fm = gid * WGM, gsz = (nM - fm) < WGM ? (nM - fm) : WGM;
        u.pm = fm + ((wgid % nig) % gsz); u.pn = (wgid % nig) / gsz; return true;
    }
    __device__ __forceinline__ void a_ready(const Unit&) const {}
    __device__ __forceinline__ void done(const Unit&) const {}
};

typedef float f32x2c_t __attribute__((ext_vector_type(2))); typedef __bf16 bf16x2c_t __attribute__((ext_vector_type(2)));
__device__ __forceinline__ unsigned cvt_pk_bf16(float lo, float hi) { const f32x2c_t v = {lo, hi}; const bf16x2c_t b = __builtin_convertvector(v, bf16x2c_t); return __builtin_bit_cast(unsigned, b); }
typedef float f32x2 __attribute__((ext_vector_type(2)));
typedef unsigned u32x2 __attribute__((ext_vector_type(2)));
__device__ __forceinline__ float sigmoidf_(float x) { return __builtin_amdgcn_rcpf(1.0f + __expf(-x)); }
__device__ __forceinline__ void store8(bf16_t* p, const f32x4 v0, const f32x4 v1) {
    u32x4 w; w.x = cvt_pk_bf16(v0[0], v0[1]); w.y = cvt_pk_bf16(v0[2], v0[3]); w.z = cvt_pk_bf16(v1[0], v1[1]); w.w = cvt_pk_bf16(v1[2], v1[3]); *(u32x4*)p = w;
}
__device__ __forceinline__ void load8(const bf16_t* p, f32x4& v0, f32x4& v1) {
    const u32x4 w = *(const u32x4*)p;
    v0[0] = __uint_as_float(w.x << 16); v0[1] = __uint_as_float(w.x & 0xffff0000u); v0[2] = __uint_as_float(w.y << 16); v0[3] = __uint_as_float(w.y & 0xffff0000u);
    v1[0] = __uint_as_float(w.z << 16); v1[1] = __uint_as_float(w.z & 0xffff0000u); v1[2] = __uint_as_float(w.w << 16); v1[3] = __uint_as_float(w.w & 0xffff0000u);
}
__device__ __forceinline__ void unpack8(const u32x4 w, f32x4& v0, f32x4& v1) {
    v0[0] = __uint_as_float(w.x << 16); v0[1] = __uint_as_float(w.x & 0xffff0000u); v0[2] = __uint_as_float(w.y << 16); v0[3] = __uint_as_float(w.y & 0xffff0000u);
    v1[0] = __uint_as_float(w.z << 16); v1[1] = __uint_as_float(w.z & 0xffff0000u); v1[2] = __uint_as_float(w.w << 16); v1[3] = __uint_as_float(w.w & 0xffff0000u);
}
template <int MODE> struct Epi {
    static constexpr bool PERM = true, AFTER_DRAIN = false;
    bf16_t* O; int ldc; const bf16_t* G; int ldg; int gcol; const float* rope; float qscale; size_t split_stride;
    bf16_t* HP; const float* ssq; const float* hg;
    __device__ __forceinline__ void operator()(const f32x4 (&acc)[2][2][4][2], const Unit& u, int wr, int wc, int fr, int fq) const {
        const int row0 = u.pm * BM + wr * 64 + fr;
        if constexpr (MODE == 1) {
            const int col0 = u.pn * HALF + wc * 32 + 8 * fq;
#pragma unroll
            for (int ai = 0; ai < 2; ++ai)
#pragma unroll
                for (int m = 0; m < 4; ++m) {
                    f32x4 o[2];
#pragma unroll
                    for (int n = 0; n < 2; ++n)
#pragma unroll
                        for (int i = 0; i < 4; ++i) { const float g = acc[ai][0][m][n][i], up = acc[ai][1][m][n][i]; o[n][i] = g * sigmoidf_(g) * up; }
                    store8(O + (size_t)(row0 + ai * HALF + m * 16) * ldc + col0, o[0], o[1]);
                }
        } else if constexpr (MODE == 3) {
            const int colt = u.pn * BM; const int t = colt / 1536;
            bf16_t* base = O + (size_t)t * split_stride;
            const int lc = colt - t * 1536 + wc * 32 + 8 * fq;
            const bool rp = (t < 2) && (wc == 0);
            const float sc = (t == 0) ? qscale : 1.0f;
            const float sgn = (fq < 2) ? -1.0f : 1.0f;
            float rf[2][4];
#pragma unroll
            for (int n = 0; n < 2; ++n)
#pragma unroll
                for (int i = 0; i < 4; ++i) rf[n][i] = __builtin_amdgcn_exp2f(-(float)(8 * (fq & 1) + 4 * n + i) * (18.931568569324174f / 16.0f)) * 0.15915494309189535f;
#pragma unroll
            for (int ai = 0; ai < 2; ++ai)
#pragma unroll
                for (int m = 0; m < 4; ++m) {
                    const int row = row0 + ai * HALF + m * 16;
                    f32x4 cs[2][2];
                    if (rp) {
                        const float pos = (float)(row & 2047);
#pragma unroll
                        for (int n = 0; n < 2; ++n)
#pragma unroll
                            for (int i = 0; i < 4; ++i) { const float rv = __builtin_amdgcn_fractf(pos * rf[n][i]); cs[n][i >> 1][2 * (i & 1)] = __builtin_amdgcn_cosf(rv); cs[n][i >> 1][2 * (i & 1) + 1] = __builtin_amdgcn_sinf(rv); }
                    }
#pragma unroll
                    for (int bj = 0; bj < 2; ++bj) {
                        f32x4 o[2];
#pragma unroll
                        for (int n = 0; n < 2; ++n) {
                            f32x4 v = acc[ai][bj][m][n];
                            if (rp) {
                                f32x4 pz;
#pragma unroll
                                for (int i = 0; i < 4; ++i) { const unsigned own = __float_as_uint(v[i]); auto sw = __builtin_amdgcn_permlane32_swap(own, own, false, false);
                                    pz[i] = __uint_as_float(sw[0] ^ sw[1] ^ own); }
                                v[0] = v[0] * cs[n][0][0] + sgn * pz[0] * cs[n][0][1];
                                v[1] = v[1] * cs[n][0][2] + sgn * pz[1] * cs[n][0][3];
                                v[2] = v[2] * cs[n][1][0] + sgn * pz[2] * cs[n][1][1];
                                v[3] = v[3] * cs[n][1][2] + sgn * pz[3] * cs[n][1][3];
                            }
                            o[n] = v * sc;
                        }
                        store8(base + (size_t)row * ldc + lc + bj * HALF, o[0], o[1]);
                    }
                }
        } else {
            const int col0 = u.pn * BM + wc * 32 + 8 * fq;
            const bool ml_tile = (MODE == 6) && (u.pn < 4);
            f32x4 hgv[2][2];
            if constexpr (MODE == 6) { if (ml_tile) {
#pragma unroll
                for (int bj = 0; bj < 2; ++bj) { hgv[bj][0] = *(const f32x4*)(hg + col0 + bj * HALF); hgv[bj][1] = *(const f32x4*)(hg + col0 + bj * HALF + 4); } } }
#pragma unroll
            for (int ai = 0; ai < 2; ++ai) {
                u32x4 gq[4][2], tq[4][2]; float rs[4];
#pragma unroll
                for (int m = 0; m < 4; ++m) {
                    const int row = row0 + ai * HALF + m * 16;
                    if constexpr (MODE == 6) { if (ml_tile) rs[m] = ssq[(size_t)row * 4 + u.pn]; }
#pragma unroll
                    for (int bj = 0; bj < 2; ++bj) {
                        if constexpr (MODE == 4 || MODE == 5) gq[m][bj] = *(const u32x4*)(G + (size_t)row * ldg + gcol + col0 + bj * HALF);
                        if constexpr (MODE == 5) tq[m][bj] = *(const u32x4*)(O + (size_t)row * ldc + col0 + bj * HALF);
                        if constexpr (MODE == 6) { if (ml_tile) tq[m][bj] = *(const u32x4*)(HP + (size_t)row * 1024 + col0 + bj * HALF); }
                    }
                }
#pragma unroll
                for (int m = 0; m < 4; ++m) {
                    const int row = row0 + ai * HALF + m * 16;
#pragma unroll
                    for (int bj = 0; bj < 2; ++bj) {
                        f32x4 v0 = acc[ai][bj][m][0], v1 = acc[ai][bj][m][1];
                        bf16_t* op = O + (size_t)row * ldc + col0 + bj * HALF;
                        if constexpr (MODE == 2 || MODE == 6) {
#pragma unroll
                            for (int i = 0; i < 4; ++i) { v0[i] = sigmoidf_(v0[i]); v1[i] = sigmoidf_(v1[i]); }
                        }
                        if constexpr (MODE == 6) {
                            if (ml_tile) {
                                const float rstd = __builtin_amdgcn_rsqf(rs[m] * (1.0f / 256.0f) + 1e-6f);
                                f32x4 h0, h1; unpack8(tq[m][bj], h0, h1);
                                store8(HP + (size_t)row * 1024 + col0 + bj * HALF, v0 * h0 * hgv[bj][0] * rstd, v1 * h1 * hgv[bj][1] * rstd);
                                continue;
                            }
                        }
                        if constexpr (MODE == 4 || MODE == 5) {
                            f32x4 g0, g1; unpack8(gq[m][bj], g0, g1);
                            v0 = v0 * g0; v1 = v1 * g1;
                            if constexpr (MODE == 5) { f32x4 t0, t1; unpack8(tq[m][bj], t0, t1); v0 = v0 + t0; v1 = v1 + t1; }
                        }
                        store8(op, v0, v1);
                    }
                }
            }
        }
    }
};
template <class Epi, class Sched, bool ALIGN_EPI = false, bool SP2 = false>
__device__ __forceinline__ void gemm_phase(PG8_LAS unsigned char* lds, const Gemm g, const Sched& S, const Epi& E) {
    int tid_l = threadIdx.x; asm volatile("" : "+v"(tid_l));
    const int tid = tid_l, wid = __builtin_amdgcn_readfirstlane(tid >> 6), lane = tid & 63, wr = wid >> 2, wc = wid & 3, fr = lane & 15, fq = lane >> 4;
    const int K = g.K, nt = K / BK;
    unsigned voffA[2], voffB[2];
#pragma unroll
    for (int i = 0; i < 2; ++i) { int R, C; stage_rc(tid * 16 + i * 8192, R, C); const int Rb = Epi::PERM ? ((R & ~31) + perm32(R & 31)) : R;
        voffA[i] = (unsigned)(R * K + C) * 2u; voffB[i] = (unsigned)(Rb * K + C) * 2u; }
    const size_t kstep = (size_t)(BK * 2);
    const size_t hstep = (size_t)HALF * K * 2;
    const size_t tstep = 2 * hstep;
    const unsigned ldsw = (unsigned)wid * 1024u;
    const int aoff = lds_byte(wr * 64 + fr, fq * 8), boff = lds_byte(wc * 32 + fr, fq * 8);
#define PG8_SA(b, h) (((b) * 2 + (h)) * HTB)
#define PG8_SB(b, h) ((4 + (b) * 2 + (h)) * HTB)
#define PG8_STAGE(bufoff, gbase, voff) do { _Pragma("unroll") for (int _i = 0; _i < 2; ++_i) \
        __builtin_amdgcn_global_load_lds((const unsigned*)((const char*)(gbase) + (voff)[_i]), (PG8_LAS unsigned*)(lds + (bufoff) + ldsw + _i * 8192), 16, 0, 0); } while (0)
#define PG8_LDA(dst, b, h) do { _Pragma("unroll") for (int m = 0; m < 4; ++m) _Pragma("unroll") for (int k = 0; k < 2; ++k) dst[m][k] = *(const PG8_LAS bf16x8*)(lds + PG8_SA(b, h) + aoff + m * 2048 + k * 1024); } while (0)
#define PG8_LDB(dst, b, h) do { _Pragma("unroll") for (int n = 0; n < 2; ++n) _Pragma("unroll") for (int k = 0; k < 2; ++k) dst[n][k] = *(const PG8_LAS bf16x8*)(lds + PG8_SB(b, h) + boff + n * 2048 + k * 1024); } while (0)
#define PG8_MMA(ai, bj, At, Bt) do { __builtin_amdgcn_s_setprio(1); _Pragma("unroll") for (int m = 0; m < 4; ++m) _Pragma("unroll") for (int n = 0; n < 2; ++n) _Pragma("unroll") for (int k = 0; k < 2; ++k) \
        acc[ai][bj][m][n] = __builtin_amdgcn_mfma_f32_16x16x32_bf16(Bt[n][k], At[m][k], acc[ai][bj][m][n], 0, 0, 0); __builtin_amdgcn_s_setprio(0); } while (0)
#define PG8_WAIT_V(n) asm volatile("s_waitcnt vmcnt(" #n ")" ::: "memory")
#define PG8_WAIT_L(n) asm volatile("s_waitcnt lgkmcnt(" #n ")" ::: "memory")
#define PG8_BAR __builtin_amdgcn_s_barrier()
#define PG8_SCHED __builtin_amdgcn_sched_barrier(0)
    Unit cur, nxt; int ui = 0;
    if (!S.next(0, cur)) return;
    f32x4 acc[2][2][4][2];
#pragma unroll
    for (int a = 0; a < 2; ++a)
#pragma unroll
        for (int b = 0; b < 2; ++b)
#pragma unroll
            for (int m = 0; m < 4; ++m)
#pragma unroll
                for (int n = 0; n < 2; ++n) acc[a][b][m][n] = (f32x4){0.f, 0.f, 0.f, 0.f};
    bf16x8 At[4][2], B0[2][2], B1[2][2];
    const char* cA = (const char*)g.A + (size_t)cur.pm * tstep; const char* cB = (const char*)g.Bt + (size_t)cur.pn * tstep;
    S.a_ready(cur);
    if constexpr (SP2) {
        PG8_STAGE(PG8_SB(0, 0), cB, voffB); PG8_STAGE(PG8_SB(0, 1), cB + hstep, voffB); PG8_STAGE(PG8_SA(0, 0), cA, voffA); PG8_STAGE(PG8_SA(0, 1), cA + hstep, voffA);
        if (wr == 1) PG8_BAR;
        PG8_WAIT_V(2); PG8_BAR;
        PG8_STAGE(PG8_SB(1, 0), cB + kstep, voffB); PG8_STAGE(PG8_SA(1, 0), cA + kstep, voffA); PG8_STAGE(PG8_SB(1, 1), cB + hstep + kstep, voffB);
        PG8_WAIT_V(6); PG8_BAR;
    } else {
        PG8_STAGE(PG8_SB(0, 0), cB, voffB); PG8_STAGE(PG8_SA(0, 0), cA, voffA); PG8_STAGE(PG8_SB(0, 1), cB + hstep, voffB); PG8_STAGE(PG8_SA(0, 1), cA + hstep, voffA);
        if (wr == 1) PG8_BAR;
        PG8_WAIT_V(4); PG8_BAR;
        PG8_STAGE(PG8_SB(1, 0), cB + kstep, voffB); PG8_STAGE(PG8_SA(1, 0), cA + kstep, voffA); PG8_STAGE(PG8_SB(1, 1), cB + hstep + kstep, voffB);
        PG8_WAIT_V(6); PG8_BAR;
    }
    for (;;) {
        const bool has_next = S.next(ui + 1, nxt);
        const char* nA = has_next ? (const char*)g.A + (size_t)nxt.pm * tstep : cA; const char* nB = has_next ? (const char*)g.Bt + (size_t)nxt.pn * tstep : cB;
        for (int t = 0; t < nt; t += 2) {
            const bool last = (t == nt - 2);
            const char* a1 = cA + (size_t)(t + 1) * kstep;
            const char* a2 = last ? nA : cA + (size_t)(t + 2) * kstep; const char* b2 = last ? nB : cB + (size_t)(t + 2) * kstep;
            const char* a3 = a2 + kstep; const char* b3 = b2 + kstep;
            if (last && has_next) S.a_ready(nxt);
            if constexpr (SP2) {
            PG8_LDB(B0, 0, 0); PG8_LDB(B1, 0, 1); PG8_SCHED; PG8_LDA(At, 0, 0); PG8_STAGE(PG8_SA(1, 1), a1 + hstep, voffA);
            PG8_WAIT_V(8); PG8_WAIT_L(0); PG8_BAR; PG8_MMA(0, 0, At, B0); PG8_MMA(0, 1, At, B1); PG8_BAR; PG8_SCHED;
            PG8_LDA(At, 0, 1); PG8_STAGE(PG8_SB(0, 0), b2, voffB); PG8_STAGE(PG8_SB(0, 1), b2 + hstep, voffB); PG8_STAGE(PG8_SA(0, 0), a2, voffA);
            PG8_WAIT_V(8); PG8_WAIT_L(0); PG8_BAR; PG8_MMA(1, 0, At, B0); PG8_MMA(1, 1, At, B1); PG8_BAR; PG8_SCHED;
            PG8_LDB(B0, 1, 0); PG8_LDB(B1, 1, 1); PG8_SCHED; PG8_LDA(At, 1, 0); PG8_STAGE(PG8_SA(0, 1), a2 + hstep, voffA);
            PG8_WAIT_V(8); PG8_WAIT_L(0); PG8_BAR; PG8_MMA(0, 0, At, B0); PG8_MMA(0, 1, At, B1); PG8_BAR; PG8_SCHED;
            PG8_LDA(At, 1, 1); PG8_STAGE(PG8_SB(1, 0), b3, voffB); PG8_STAGE(PG8_SB(1, 1), b3 + hstep, voffB); PG8_STAGE(PG8_SA(1, 0), a3, voffA);
            PG8_WAIT_V(8); PG8_WAIT_L(0); PG8_BAR; PG8_MMA(1, 0, At, B0); PG8_MMA(1, 1, At, B1); PG8_BAR; PG8_SCHED;
            } else {
            PG8_LDB(B0, 0, 0); PG8_SCHED; PG8_LDA(At, 0, 0); PG8_STAGE(PG8_SA(1, 1), a1 + hstep, voffA);
            PG8_WAIT_L(8); PG8_BAR; PG8_WAIT_L(0); PG8_MMA(0, 0, At, B0); PG8_BAR; PG8_SCHED;
            PG8_LDB(B1, 0, 1); PG8_STAGE(PG8_SB(0, 0), b2, voffB);
            PG8_BAR; PG8_WAIT_L(0); PG8_MMA(0, 1, At, B1); PG8_BAR;
            PG8_LDA(At, 0, 1); PG8_STAGE(PG8_SA(0, 0), a2, voffA);
            PG8_BAR; PG8_WAIT_L(0); PG8_MMA(1, 0, At, B0); PG8_BAR; PG8_SCHED;
            PG8_STAGE(PG8_SB(0, 1), b2 + hstep, voffB);
            PG8_WAIT_V(6); PG8_BAR; PG8_MMA(1, 1, At, B1); PG8_BAR;
            PG8_LDB(B0, 1, 0); PG8_SCHED; PG8_LDA(At, 1, 0); PG8_STAGE(PG8_SA(0, 1), a2 + hstep, voffA);
            PG8_WAIT_L(8); PG8_BAR; PG8_WAIT_L(0); PG8_MMA(0, 0, At, B0); PG8_BAR; PG8_SCHED;
            PG8_LDB(B1, 1, 1); PG8_STAGE(PG8_SB(1, 0), b3, voffB);
            PG8_BAR; PG8_WAIT_L(0); PG8_MMA(0, 1, At, B1); PG8_BAR;
            PG8_LDA(At, 1, 1); PG8_STAGE(PG8_SA(1, 0), a3, voffA);
            PG8_BAR; PG8_WAIT_L(0); PG8_MMA(1, 0, At, B0); PG8_BAR; PG8_SCHED;
            PG8_STAGE(PG8_SB(1, 1), b3 + hstep, voffB);
            PG8_WAIT_V(6); PG8_BAR; PG8_MMA(1, 1, At, B1); PG8_BAR;
            }
        }
        if constexpr (ALIGN_EPI) { if (wr == 0) PG8_BAR; }
        if constexpr (!Epi::AFTER_DRAIN) { E(acc, cur, wr, wc, fr, fq); S.done(cur); }
        if (!has_next) break;
#pragma unroll
        for (int a = 0; a < 2; ++a)
#pragma unroll
            for (int b = 0; b < 2; ++b)
#pragma unroll
                for (int m = 0; m < 4; ++m)
#pragma unroll
                    for (int n = 0; n < 2; ++n) acc[a][b][m][n] = (f32x4){0.f, 0.f, 0.f, 0.f};
        cur = nxt; cA = nA; cB = nB; ++ui;
        if constexpr (ALIGN_EPI) { if (wr == 1) PG8_BAR; }
    }
    PG8_WAIT_V(0);
    if constexpr (!ALIGN_EPI) { if (wr == 0) PG8_BAR; }
    PG8_BAR;
    if constexpr (Epi::AFTER_DRAIN) { E.fused(acc, cur, wr, wc, fr, fq, lds, wid, lane); S.done(cur); }
#undef PG8_SA
#undef PG8_SB
#undef PG8_STAGE
#undef PG8_LDA
#undef PG8_LDB
#undef PG8_MMA
#undef PG8_WAIT_V
#undef PG8_WAIT_L
#undef PG8_BAR
#undef PG8_SCHED
}
}

using pg8::bf16_t; using pg8::bf16x8; using pg8::f32x4; using pg8::u32x4; using pg8::u32x2; using pg8::cvt_pk_bf16;
#define LAS __attribute__((address_space(3)))
typedef short s16x4 __attribute__((ext_vector_type(4)));
constexpr int DM = 1024, BATCH = 8, SEQ = 2048, M = BATCH * SEQ, DFF = 2816, INW = 10760;
constexpr float EPS = 1e-6f;
constexpr size_t MiB = 1u << 20;
constexpr size_t WS_SSQ = 256 * 1024;
constexpr size_t WS_IF = 1 * MiB;
constexpr size_t WS_LSE = WS_IF + 512 * 1024;
constexpr size_t WS_ROPE = WS_LSE + 768 * 1024;
constexpr size_t WS_GT = WS_ROPE + 256 * 1024;
constexpr size_t WS_WGU1 = 4 * MiB;
constexpr size_t WS_WD1 = WS_WGU1 + (size_t)5632 * 1024 * 2;
constexpr size_t WS_WGU2 = WS_WD1 + (size_t)1024 * 2816 * 2;
constexpr size_t WS_WD2 = WS_WGU2 + (size_t)5632 * 1024 * 2;
constexpr size_t WS_WIN = WS_WD2 + (size_t)1024 * 2816 * 2;
constexpr size_t WS_WA = WS_WIN + (size_t)10752 * 1024 * 2;
constexpr size_t WS_WM = WS_WA + (size_t)1024 * 512 * 2;
constexpr size_t WS_WO = WS_WM + (size_t)1024 * 1024 * 2;
constexpr size_t WS_WEND = WS_WO + (size_t)1024 * 1024 * 2;
static_assert(WS_WEND <= 63 * MiB, "weights");
constexpr size_t WS_H = 63 * MiB;
constexpr size_t WS_ACT = 95 * MiB;
constexpr size_t WS_F = 183 * MiB;
constexpr size_t WS_Q = 95 * MiB;
constexpr size_t WS_ATT = 239 * MiB;
constexpr size_t WS_QKMV = 143 * MiB;
constexpr size_t WS_HPRE = 95 * MiB;
constexpr size_t WS_OG = 143 * MiB;
constexpr size_t WS_Y = 143 * MiB;
constexpr size_t WS_END = 256 * MiB;
constexpr int LDS_BYTES = 147456, RING_BYTES = 131072;

struct Args {
    const float* in[22]; float* out; unsigned char* ws;
};

__device__ __forceinline__ float wave_sum(float v) {
#pragma unroll
    for (int o = 1; o < 64; o <<= 1) v += __shfl_xor(v, o);
    return v;
}
__device__ __forceinline__ float wave_max(float v) {
#pragma unroll
    for (int o = 1; o < 64; o <<= 1) v = fmaxf(v, __shfl_xor(v, o));
    return v;
}
__device__ __forceinline__ unsigned f2bf(float f) { unsigned u = __float_as_uint(f); return (u + 0x7fffu + ((u >> 16) & 1u)) >> 16; }
__device__ __forceinline__ unsigned pk2(float lo, float hi) { return cvt_pk_bf16(lo, hi); }
__device__ __forceinline__ float bf_lo(unsigned w) { return __uint_as_float(w << 16); }
__device__ __forceinline__ float bf_hi(unsigned w) { return __uint_as_float(w & 0xffff0000u); }
__device__ __forceinline__ s16x4 vtr(const LAS unsigned char* p) { typedef short v4i16_t __attribute__((ext_vector_type(4))); return __builtin_bit_cast(s16x4, __builtin_amdgcn_ds_read_tr16_b64_v4i16((LAS v4i16_t*)p)); }
__device__ __forceinline__ bf16x8 cat8(s16x4 a, s16x4 b) { return (bf16x8){a[0], a[1], a[2], a[3], b[0], b[1], b[2], b[3]}; }
#define MFMA16(a, b, c) __builtin_amdgcn_mfma_f32_16x16x32_bf16((a), (b), (c), 0, 0, 0)

__device__ __forceinline__ void tr_item(const float* W, int ldw, int col0, int k0, bf16_t* WT, int K, int drow0, LAS float* scr, int lane) {
    const int r8 = lane >> 3, c4 = lane & 7;
    f32x4 v[8];
#pragma unroll
    for (int i = 0; i < 8; ++i) v[i] = *(const f32x4*)(W + (size_t)(k0 + r8 + 8 * i) * ldw + col0 + 4 * c4);
#pragma unroll
    for (int i = 0; i < 8; ++i) { LAS float* d = scr + (r8 + 8 * i) * 33 + 4 * c4; d[0] = v[i][0]; d[1] = v[i][1]; d[2] = v[i][2]; d[3] = v[i][3]; }
    asm volatile("s_waitcnt lgkmcnt(0)" ::: "memory");
    const int c = lane & 7;
#pragma unroll
    for (int j = 0; j < 4; ++j) { const int n = (lane >> 3) + 8 * j; const LAS float* s = scr + (8 * c) * 33 + n;
        u32x4 o; o.x = pk2(s[0 * 33], s[1 * 33]); o.y = pk2(s[2 * 33], s[3 * 33]); o.z = pk2(s[4 * 33], s[5 * 33]); o.w = pk2(s[6 * 33], s[7 * 33]);
        *(u32x4*)(WT + (size_t)(drow0 + n) * K + k0 + 8 * c) = o; }
    asm volatile("s_waitcnt lgkmcnt(0)" ::: "memory");
}

template <bool HAS_BR, bool WRITE_RES, bool WRITE_NORM, bool DO_IF>
__device__ __forceinline__ void rowpass(int gw, int ngw, int lane, const float* res, const bf16_t* br, float coef, const float* gbr, float* outres,
                                        const float* gn, bf16_t* outn, const LAS f32x4* wif, float* IF) {
    for (int row0 = gw; row0 < M; row0 += 2 * ngw) {
        f32x4 v[2][4]; u32x2 bw[2][4];
#pragma unroll
        for (int r = 0; r < 2; ++r) { const int row = (row0 + r * ngw < M) ? row0 + r * ngw : row0;
#pragma unroll
            for (int j = 0; j < 4; ++j) { v[r][j] = *((const f32x4*)(res + (size_t)row * DM) + lane + 64 * j);
                if constexpr (HAS_BR) bw[r][j] = *((const u32x2*)(br + (size_t)row * DM) + lane + 64 * j); } }
#pragma unroll
        for (int r = 0; r < 2; ++r) {
            const int row = row0 + r * ngw; if (row >= M) break;
            if constexpr (HAS_BR) {
                f32x4 b[4]; float ss = 0.f;
#pragma unroll
                for (int j = 0; j < 4; ++j) { const u32x2 w = bw[r][j];
                    b[j][0] = bf_lo(w.x); b[j][1] = bf_hi(w.x); b[j][2] = bf_lo(w.y); b[j][3] = bf_hi(w.y);
                    ss += (b[j][0] * b[j][0] + b[j][1] * b[j][1]) + (b[j][2] * b[j][2] + b[j][3] * b[j][3]); }
                const float rstd = coef * __builtin_amdgcn_rsqf(wave_sum(ss) * (1.0f / DM) + EPS);
#pragma unroll
                for (int j = 0; j < 4; ++j) { const f32x4 g = *((const f32x4*)gbr + lane + 64 * j); v[r][j] = v[r][j] + b[j] * g * rstd; }
            }
            if constexpr (WRITE_RES) {
#pragma unroll
                for (int j = 0; j < 4; ++j) *((f32x4*)(outres + (size_t)row * DM) + lane + 64 * j) = v[r][j];
            }
            if constexpr (WRITE_NORM) {
                float ss = 0.f;
#pragma unroll
                for (int j = 0; j < 4; ++j) ss += (v[r][j][0] * v[r][j][0] + v[r][j][1] * v[r][j][1]) + (v[r][j][2] * v[r][j][2] + v[r][j][3] * v[r][j][3]);
                const float rstd = __builtin_amdgcn_rsqf(wave_sum(ss) * (1.0f / DM) + EPS);
                f32x4 hn[4];
#pragma unroll
                for (int j = 0; j < 4; ++j) { const f32x4 g = *((const f32x4*)gn + lane + 64 * j); hn[j] = v[r][j] * g * rstd;
                    u32x2 w; w.x = pk2(hn[j][0], hn[j][1]); w.y = pk2(hn[j][2], hn[j][3]); *((u32x2*)(outn + (size_t)row * DM) + lane + 64 * j) = w; }
                if constexpr (DO_IF) {
                    f32x4 a0 = {0.f, 0.f, 0.f, 0.f}, a1 = {0.f, 0.f, 0.f, 0.f};
#pragma unroll
                    for (int j = 0; j < 4; ++j)
#pragma unroll
                        for (int e = 0; e < 4; ++e) { const f32x4 w0 = wif[((j * 4 + e) * 2 + 0) * 64 + lane], w1 = wif[((j * 4 + e) * 2 + 1) * 64 + lane];
                            a0 = a0 + w0 * hn[j][e]; a1 = a1 + w1 * hn[j][e]; }
                    float rr[8];
#pragma unroll
                    for (int c = 0; c < 4; ++c) { rr[c] = wave_sum(a0[c]); rr[4 + c] = wave_sum(a1[c]); }
                    if (lane == 0) { *(f32x4*)(IF + (size_t)row * 8) = (f32x4){rr[0], rr[1], rr[2], rr[3]}; *(f32x4*)(IF + (size_t)row * 8 + 4) = (f32x4){rr[4], rr[5], rr[6], rr[7]}; }
                }
            }
        }
    }
}

__device__ __forceinline__ void attn_item(LAS unsigned char* lds, bf16_t* Qb, const bf16_t* Kb, const bf16_t* Vb, float* LSE, int it, int tid, int wave, int lane) {
    const int g = it >> 9, rem = it & 511, b = rem >> 6, slot = (rem >> 4) & 3, x = rem & 15;
    int dil, r, blk;
    if (g == 0) { dil = 1; r = 0; blk = x; } else if (g == 1) { dil = 4; r = x >> 2; blk = x & 3; } else { dil = 16; r = x; blk = 0; }
    const int q0 = blk * 128, cb = g * 512 + slot * 128;
    const int fr = lane & 15, fq = lane >> 4;
    LAS unsigned char* KS = lds; LAS unsigned char* VS = lds + 65536;
    {
        u32x4 kv[8], vv[8];
#pragma unroll
        for (int i = 0; i < 8; ++i) {
            const int id = tid + 512 * i, row = id >> 4, ch = id & 15, kn = q0 - 128 + row, knc = kn < 0 ? 0 : kn;
            const size_t off = (size_t)(b * SEQ + knc * dil + r) * 1536 + cb + ch * 8; kv[i] = *(const u32x4*)(Kb + off); vv[i] = *(const u32x4*)(Vb + off);
        }
#pragma unroll
        for (int i = 0; i < 8; ++i) {
            const int id = tid + 512 * i, row = id >> 4, ch = id & 15, kn = q0 - 128 + row;
            const u32x4 z = {0u, 0u, 0u, 0u};
            *(LAS u32x4*)(KS + row * 256 + ((ch ^ (row & 15)) << 4)) = kn < 0 ? z : kv[i];
            *(LAS u32x4*)(VS + row * 256 + ((ch ^ ((row & 7) << 1)) << 4)) = kn < 0 ? z : vv[i];
        }
    }
    const int qn = q0 + 16 * wave + fr; const size_t qrow = (size_t)(b * SEQ + qn * dil + r);
    bf16x8 qf[4];
#pragma unroll
    for (int ks = 0; ks < 4; ++ks) qf[ks] = *(const bf16x8*)(Qb + qrow * 1536 + cb + 32 * ks + 8 * fq);
    __syncthreads();
    f32x4 sa[9];
#pragma unroll
    for (int j = 0; j < 9; ++j) {
        const int krow = 16 * (wave + j) + fr;
        f32x4 a = {0.f, 0.f, 0.f, 0.f};
#pragma unroll
        for (int ks = 0; ks < 4; ++ks) {
            const bf16x8 kf = *(const LAS bf16x8*)(KS + krow * 256 + (((4 * ks + fq) ^ (krow & 15)) << 4));
            a = MFMA16(kf, qf[ks], a);
        }
        sa[j] = a;
    }
    const int kmin = 128 - q0;
    float mx = -INFINITY;
#pragma unroll
    for (int j = 0; j < 9; ++j)
#pragma unroll
        for (int i = 0; i < 4; ++i) { const int rel = 16 * j + 4 * fq + i - fr, kidx = 16 * (wave + j) + 4 * fq + i;
            const bool ok = (rel >= 0) && (rel <= 128) && (kidx >= kmin);
            sa[j][i] = ok ? sa[j][i] : -INFINITY; mx = fmaxf(mx, sa[j][i]); }
    mx = fmaxf(mx, __shfl_xor(mx, 16)); mx = fmaxf(mx, __shfl_xor(mx, 32));
    float l = 0.f;
#pragma unroll
    for (int j = 0; j < 9; ++j)
#pragma unroll
        for (int i = 0; i < 4; ++i) { const float p = __builtin_amdgcn_exp2f(sa[j][i] - mx); sa[j][i] = p; l += p; }
    l += __shfl_xor(l, 16); l += __shfl_xor(l, 32);
    f32x4 oa[8];
#pragma unroll
    for (int dt = 0; dt < 8; ++dt) oa[dt] = (f32x4){0.f, 0.f, 0.f, 0.f};
    const int tq = fr >> 2, tp = fr & 3;
#pragma unroll
    for (int s2 = 0; s2 < 5; ++s2) {
        u32x4 pw;
        pw.x = pk2(sa[2 * s2][0], sa[2 * s2][1]); pw.y = pk2(sa[2 * s2][2], sa[2 * s2][3]);
        if (s2 < 4) { pw.z = pk2(sa[2 * s2 + 1][0], sa[2 * s2 + 1][1]); pw.w = pk2(sa[2 * s2 + 1][2], sa[2 * s2 + 1][3]); } else { pw.z = 0u; pw.w = 0u; }
        const bf16x8 pf = __builtin_bit_cast(bf16x8, pw);
        int ta = wave + 2 * s2, tb = wave + 2 * s2 + 1; if (tb > 15) tb = 15;
        const int ra = 16 * ta + 4 * fq + tq, rb = 16 * tb + 4 * fq + tq;
#pragma unroll
        for (int dt = 0; dt < 8; ++dt) {
            const int g8 = 4 * dt + tp;
            const s16x4 va = vtr(VS + ra * 256 + ((g8 ^ ((ra & 7) << 2)) << 3));
            const s16x4 vb = vtr(VS + rb * 256 + ((g8 ^ ((rb & 7) << 2)) << 3));
            oa[dt] = MFMA16(cat8(va, vb), pf, oa[dt]);
        }
    }
    const float inv = 1.0f / l;
#pragma unroll
    for (int dt = 0; dt < 8; ++dt) { u32x2 w; w.x = pk2(oa[dt][0] * inv, oa[dt][1] * inv); w.y = pk2(oa[dt][2] * inv, oa[dt][3] * inv);
        *(u32x2*)(Qb + qrow * 1536 + cb + 16 * dt + 4 * fq) = w; }
    if (fq == 0) LSE[qrow * 12 + g * 4 + slot] = (mx + __builtin_amdgcn_logf(l)) * 0.6931471805599453f;
    __syncthreads();
}

constexpr int ML_QS = 0, ML_KS = 33792, ML_CB = 67584, ML_VE = 92928, ML_AV = 99072, ML_WW = 105216, ML_NUM = 114432, ML_SC = 127744;
constexpr int ML_P = 528;
__device__ __forceinline__ float scan_sum(float v, int lane) {
#pragma unroll
    for (int o = 1; o < 64; o <<= 1) { const float t = __shfl_up(v, o); if (lane >= o) v += t; }
    return v;
}
__device__ __forceinline__ float scan_max(float v, int lane) {
#pragma unroll
    for (int o = 1; o < 64; o <<= 1) { const float t = __shfl_up(v, o); if (lane >= o) v = fmaxf(v, t); }
    return v;
}
struct ConvHalo { u32x4 h0, h1, h2; };
__device__ __forceinline__ void bf8_to_f(const u32x4 w, float* d) { d[0] = bf_lo(w.x); d[1] = bf_hi(w.x); d[2] = bf_lo(w.y); d[3] = bf_hi(w.y); d[4] = bf_lo(w.z); d[5] = bf_hi(w.z); d[6] = bf_lo(w.w); d[7] = bf_hi(w.w); }
__device__ __forceinline__ void conv_halo(const bf16_t* QKMV, int gid, ConvHalo& H) {
    const int cg = gid & 255, rest = gid >> 8, b = rest >> 6, t0 = (rest & 63) * 32;
    const bf16_t* base = QKMV + (size_t)(b * SEQ) * 3072 + cg * 8;
    H.h0 = (u32x4){0u, 0u, 0u, 0u}; H.h1 = H.h0; H.h2 = H.h0;
    if (t0 > 0) { H.h0 = *(const u32x4*)(base + (size_t)(t0 - 3) * 3072); H.h1 = *(const u32x4*)(base + (size_t)(t0 - 2) * 3072); H.h2 = *(const u32x4*)(base + (size_t)(t0 - 1) * 3072); }
}
__device__ __forceinline__ void conv_run(bf16_t* QKMV, const float* conv_w, const float* conv_b, int gid, const ConvHalo& H) {
    const int cg = gid & 255, rest = gid >> 8, b = rest >> 6, t0 = (rest & 63) * 32;
    bf16_t* base = QKMV + (size_t)(b * SEQ) * 3072 + cg * 8;
    float cw[4][8], cbv[8];
#pragma unroll
    for (int j = 0; j < 4; ++j) { const f32x4 a = *(const f32x4*)(conv_w + j * 2048 + cg * 8), c = *(const f32x4*)(conv_w + j * 2048 + cg * 8 + 4);
        cw[j][0] = a[0]; cw[j][1] = a[1]; cw[j][2] = a[2]; cw[j][3] = a[3]; cw[j][4] = c[0]; cw[j][5] = c[1]; cw[j][6] = c[2]; cw[j][7] = c[3]; }
    { const f32x4 a = *(const f32x4*)(conv_b + cg * 8), c = *(const f32x4*)(conv_b + cg * 8 + 4);
        cbv[0] = a[0]; cbv[1] = a[1]; cbv[2] = a[2]; cbv[3] = a[3]; cbv[4] = c[0]; cbv[5] = c[1]; cbv[6] = c[2]; cbv[7] = c[3]; }
    const float kscale = (cg < 128) ? 1.0f : 0.0625f;
    float x0[8], x1[8], x2[8];
    bf8_to_f(H.h0, x0); bf8_to_f(H.h1, x1); bf8_to_f(H.h2, x2);
    for (int tb = 0; tb < 32; tb += 8) {
        u32x4 raw[8];
#pragma unroll
        for (int r = 0; r < 8; ++r) raw[r] = *(const u32x4*)(base + (size_t)(t0 + tb + r) * 3072);
#pragma unroll
        for (int r = 0; r < 8; ++r) {
            float x3[8], o[8]; bf8_to_f(raw[r], x3);
#pragma unroll
            for (int e = 0; e < 8; ++e) { const float sv = cbv[e] + cw[0][e] * x0[e] + cw[1][e] * x1[e] + cw[2][e] * x2[e] + cw[3][e] * x3[e];
                o[e] = sv * __builtin_amdgcn_rcpf(1.0f + __expf(-sv)) * kscale; x0[e] = x1[e]; x1[e] = x2[e]; x2[e] = x3[e]; }
            u32x4 w; w.x = pk2(o[0], o[1]); w.y = pk2(o[2], o[3]); w.z = pk2(o[4], o[5]); w.w = pk2(o[6], o[7]);
            *(u32x4*)(base + (size_t)(t0 + tb + r) * 3072) = w;
        }
    }
}

__device__ __forceinline__ void gates_prepass(LAS unsigned char* lds, const float* IF, const float* i_bias, const float* f_bias, float* GT, int bh, int tid, int wave, int lane) {
    const int b = bh >> 2, h = bh & 3;
    LAS float* BT = (LAS float*)lds; LAS float* IB = BT + 2048; LAS float* CM = IB + 2048; LAS float* BL = CM + 2048; LAS float* GM = BL + 32; LAS float* MS = GM + 32;
    const float ib_h = i_bias[h], fb_h = f_bias[h];
    for (int c = wave; c < 32; c += 8) {
        const size_t row = (size_t)b * SEQ + 64 * c + lane;
        const float ipre = IF[row * 8 + h] + ib_h, fpre = IF[row * 8 + 4 + h] + fb_h;
        const float lf = fminf(fpre, 0.f) - log1pf(__expf(-fabsf(fpre)));
        const float bt = scan_sum(lf, lane), ib = ipre - bt, cm = scan_max(ib, lane), bl = __shfl(bt, 63), gm = wave_max(bl + ib);
        BT[64 * c + lane] = bt; IB[64 * c + lane] = ib; CM[64 * c + lane] = cm;
        if (lane == 0) { BL[c] = bl; GM[c] = gm; }
    }
    __syncthreads();
    if (tid == 0) { float m = 0.f; MS[0] = 0.f; for (int c = 0; c < 32; ++c) { m = fmaxf(BL[c] + m, GM[c]); MS[c + 1] = m; } }
    __syncthreads();
    for (int c = wave; c < 32; c += 8) {
        const float bt = BT[64 * c + lane], ib = IB[64 * c + lane], cm = CM[64 * c + lane], bl = BL[c], mc = MS[c], mn = MS[c + 1];
        const float mt = bt + fmaxf(mc, cm);
        float* g = GT + ((size_t)bh * 32 + c) * 384;
        g[lane] = ib; g[64 + lane] = bt - mt; g[128 + lane] = __expf(bt + mc - mt); g[192 + lane] = __expf(-mt); g[256 + lane] = __expf(bl + ib - mn); g[320 + lane] = __expf(bl + mc - mn);
    }
    __syncthreads();
}

__device__ __forceinline__ void mlstm_item(LAS unsigned char* lds, const bf16_t* QKMV, const float* GT, bf16_t* HPRE, float* SSQ, int it, int tid, int wave, int lane) {
    const int b = it >> 5, h = (it >> 3) & 3, sl = it & 7;
    const int fr = lane & 15, fq = lane >> 4, tq = fr >> 2, tp = fr & 3;
    LAS float* SC = (LAS float*)(lds + ML_SC);
    for (int i = tid; i < 25344 / 4; i += 512) ((LAS unsigned*)(lds + ML_CB))[i] = 0u;
    const int cch = (lane < 32 ? 0 : 1024) + h * 256 + (lane & 31) * 8;
    f32x4 cacc[2][3];
#pragma unroll
    for (int a = 0; a < 2; ++a)
#pragma unroll
        for (int v = 0; v < 3; ++v) cacc[a][v] = (f32x4){0.f, 0.f, 0.f, 0.f};
    const size_t rowb = (size_t)b * SEQ;
    const float* gt = GT + (size_t)(b * 4 + h) * 32 * 384;
    const int tg = wave;
    u32x4 xraw[8]; u32x4 vraw = {0u, 0u, 0u, 0u}; float gpre = 0.f;
#define ML_PREFETCH(c_) do { const int t0_ = 64 * (c_); \
        _Pragma("unroll") for (int rr = 0; rr < 8; ++rr) xraw[rr] = *(const u32x4*)(QKMV + (rowb + t0_ + 8 * tg + rr) * 3072 + cch); \
        if (wave < 4) vraw = *(const u32x4*)(QKMV + (rowb + t0_ + (tid >> 2)) * 3072 + 2048 + h * 256 + sl * 32 + (tid & 3) * 8); \
        if (tid < 384) gpre = gt[(c_) * 384 + tid]; } while (0)
    ML_PREFETCH(0);
    for (int c = 0; c < 32; ++c) {
        const int t0 = 64 * c;
        {
            LAS unsigned char* dst = lds + (lane < 32 ? ML_QS : ML_KS) + (lane & 31) * 16;
#pragma unroll
            for (int tt = 0; tt < 8; ++tt) *(LAS u32x4*)(dst + (8 * tg + tt) * ML_P) = xraw[tt];
        }
        if (wave < 4) { *(LAS u32x4*)(lds + ML_VE + (tid >> 2) * 96 + (tid & 3) * 16) = vraw; }
        else if (wave == 4) { *(LAS u32x4*)(lds + ML_VE + lane * 96 + 64) = (u32x4){0x3f80u, 0u, 0u, 0u}; *(LAS u32x4*)(lds + ML_VE + lane * 96 + 80) = (u32x4){0u, 0u, 0u, 0u}; }
        if (tid < 384) SC[tid] = gpre;
#if !defined(MLV) || !(MLV & 1)
        for (int i = tid; i < 64 * 52; i += 512) ((LAS float*)(lds + ML_NUM))[i] = 0.f;
#endif
        if (c + 1 < 32) ML_PREFETCH(c + 1);
        __syncthreads();
        if (wave < 4) {
            const int t = tid >> 2, c8 = tid & 3; const float at = SC[256 + t];
            const u32x4 w = *(const LAS u32x4*)(lds + ML_VE + t * 96 + c8 * 16);
            u32x4 o; o.x = pk2(bf_lo(w.x) * at, bf_hi(w.x) * at); o.y = pk2(bf_lo(w.y) * at, bf_hi(w.y) * at); o.z = pk2(bf_lo(w.z) * at, bf_hi(w.z) * at); o.w = pk2(bf_lo(w.w) * at, bf_hi(w.w) * at);
            *(LAS u32x4*)(lds + ML_AV + t * 96 + c8 * 16) = o;
        } else if (wave == 4) {
            *(LAS u32x4*)(lds + ML_AV + lane * 96 + 64) = (u32x4){f2bf(SC[256 + lane]), 0u, 0u, 0u}; *(LAS u32x4*)(lds + ML_AV + lane * 96 + 80) = (u32x4){0u, 0u, 0u, 0u};
        }
        {
            const int tt = wave >> 1;
#pragma unroll
            for (int u = 0; u < 2; ++u) {
                const int st = 2 * (wave & 1) + u;
                f32x4 a = {0.f, 0.f, 0.f, 0.f};
                if (st <= tt) {
#pragma unroll
                    for (int ks = 0; ks < 8; ++ks) {
                        const bf16x8 kf = *(const LAS bf16x8*)(lds + ML_KS + (16 * st + fr) * ML_P + 64 * ks + 16 * fq);
                        const bf16x8 qf = *(const LAS bf16x8*)(lds + ML_QS + (16 * tt + fr) * ML_P + 64 * ks + 16 * fq);
                        a = MFMA16(kf, qf, a);
                    }
                }
                const int t = 16 * tt + fr; const float bmt = SC[64 + t];
                float w[4];
#pragma unroll
                for (int i = 0; i < 4; ++i) { const int s2 = 16 * st + 4 * fq + i; w[i] = (s2 <= t) ? __expf(bmt + SC[s2]) * a[i] : 0.f; }
                u32x2 o; o.x = pk2(w[0], w[1]); o.y = pk2(w[2], w[3]);
                *(LAS u32x2*)(lds + ML_WW + t * 144 + (16 * st + 4 * fq) * 2) = o;
            }
        }
        __syncthreads();
#if defined(MLV) && (MLV & 1)
        for (int tile = wave; tile < 12; tile += 8) {
            const int tt = tile & 3, vt = tile >> 2;
            f32x4 aw = {0.f, 0.f, 0.f, 0.f}, ac = {0.f, 0.f, 0.f, 0.f};
#pragma unroll
            for (int k2 = 0; k2 < 2; ++k2) {
                const bf16x8 wf = *(const LAS bf16x8*)(lds + ML_WW + (16 * tt + fr) * 144 + 64 * k2 + 16 * fq);
                const LAS unsigned char* vp = lds + ML_VE + (32 * k2 + 8 * fq + tq) * 96 + (16 * vt + 4 * tp) * 2;
                aw = MFMA16(wf, cat8(vtr(vp), vtr(vp + 4 * 96)), aw);
            }
#pragma unroll
            for (int ks = 0; ks < 8; ++ks) {
                const bf16x8 qf = *(const LAS bf16x8*)(lds + ML_QS + (16 * tt + fr) * ML_P + 64 * ks + 16 * fq);
                const bf16x8 cf = *(const LAS bf16x8*)(lds + ML_CB + (16 * vt + fr) * ML_P + 64 * ks + 16 * fq);
                ac = MFMA16(qf, cf, ac);
            }
#pragma unroll
            for (int i = 0; i < 4; ++i) { const int t = 16 * tt + 4 * fq + i; ((LAS float*)(lds + ML_NUM))[t * 52 + 16 * vt + fr] = aw[i] + SC[128 + t] * ac[i]; }
        }
#else
        {
            const int tt = wave & 3, hf = wave >> 2;
            f32x4 aw[3], ac[3];
#pragma unroll
            for (int vt = 0; vt < 3; ++vt) { aw[vt] = (f32x4){0.f, 0.f, 0.f, 0.f}; ac[vt] = (f32x4){0.f, 0.f, 0.f, 0.f}; }
            {
                const bf16x8 wf = *(const LAS bf16x8*)(lds + ML_WW + (16 * tt + fr) * 144 + 64 * hf + 16 * fq);
#pragma unroll
                for (int vt = 0; vt < 3; ++vt) {
                    const LAS unsigned char* vp = lds + ML_VE + (32 * hf + 8 * fq + tq) * 96 + (16 * vt + 4 * tp) * 2;
                    aw[vt] = MFMA16(wf, cat8(vtr(vp), vtr(vp + 4 * 96)), aw[vt]);
                }
            }
#pragma unroll
            for (int k4 = 0; k4 < 4; ++k4) {
                const int ks = 4 * hf + k4;
                const bf16x8 qf = *(const LAS bf16x8*)(lds + ML_QS + (16 * tt + fr) * ML_P + 64 * ks + 16 * fq);
#pragma unroll
                for (int vt = 0; vt < 3; ++vt) {
                    const bf16x8 cf = *(const LAS bf16x8*)(lds + ML_CB + (16 * vt + fr) * ML_P + 64 * ks + 16 * fq);
                    ac[vt] = MFMA16(qf, cf, ac[vt]);
                }
            }
#pragma unroll
            for (int i = 0; i < 4; ++i) { const int t = 16 * tt + 4 * fq + i; const float in = SC[128 + t];
#pragma unroll
                for (int vt = 0; vt < 3; ++vt) atomicAdd((float*)((LAS float*)(lds + ML_NUM) + t * 52 + 16 * vt + fr), aw[vt][i] + in * ac[vt][i]); }
        }
#endif
        __syncthreads();
        {
            const int t = tid >> 3, v4 = (tid & 7) * 4;
            const LAS float* nr = (const LAS float*)(lds + ML_NUM) + t * 52;
            const float den = fmaxf(fabsf(nr[32]), SC[192 + t]); const float inv = 1.0f / den;
            const f32x4 nv = *(const LAS f32x4*)(nr + v4);
            const f32x4 hv = nv * inv;
            u32x2 o; o.x = pk2(hv[0], hv[1]); o.y = pk2(hv[2], hv[3]);
            *(u32x2*)(HPRE + (rowb + t0 + t) * 1024 + h * 256 + sl * 32 + v4) = o;
            float sq = (hv[0] * hv[0] + hv[1] * hv[1]) + (hv[2] * hv[2] + hv[3] * hv[3]);
            sq += __shfl_xor(sq, 1); sq += __shfl_xor(sq, 2); sq += __shfl_xor(sq, 4);
            if ((tid & 7) == 0) atomicAdd(SSQ + (rowb + t0 + t) * 4 + h, sq);
        }
        {
            const float decay = SC[320];
#pragma unroll
            for (int a = 0; a < 2; ++a) {
                const int kt = 2 * wave + a;
                bf16x8 kf[2];
#pragma unroll
                for (int k2 = 0; k2 < 2; ++k2) {
                    const LAS unsigned char* kp = lds + ML_KS + (32 * k2 + 8 * fq + tq) * ML_P + (16 * kt + 4 * tp) * 2;
                    kf[k2] = cat8(vtr(kp), vtr(kp + 4 * ML_P));
                }
#pragma unroll
                for (int vt = 0; vt < 3; ++vt) {
                    f32x4 acc = cacc[a][vt] * decay;
#pragma unroll
                    for (int k2 = 0; k2 < 2; ++k2) {
                        const LAS unsigned char* vp = lds + ML_AV + (32 * k2 + 8 * fq + tq) * 96 + (16 * vt + 4 * tp) * 2;
                        acc = MFMA16(kf[k2], cat8(vtr(vp), vtr(vp + 4 * 96)), acc);
                    }
                    cacc[a][vt] = acc;
                    u32x2 o; o.x = pk2(acc[0], acc[1]); o.y = pk2(acc[2], acc[3]);
                    *(LAS u32x2*)(lds + ML_CB + (16 * vt + fr) * ML_P + (16 * kt + 4 * fq) * 2) = o;
                }
            }
        }
        __syncthreads();
    }
#undef ML_PREFETCH
}

#define XB_TMO      128
#define XB_XCNT(j)  (256  + 64 * (j))
#define XB_XSUB(j)  (1280 + 64 * (j))
#define XB_XGEN(j)  (2304 + 64 * (j))
#define XB_TOP      3328
#define XB_TOPGEN   3392
#define XCD_BAR_WORDS 3456
#define XB_SPIN_CAP (1u << 18)

__device__ __forceinline__ unsigned xb_ld(unsigned* p)              { return __hip_atomic_load(p, __ATOMIC_RELAXED, __HIP_MEMORY_SCOPE_AGENT); }
__device__ __forceinline__ unsigned xb_add(unsigned* p, unsigned v) { return __hip_atomic_fetch_add(p, v, __ATOMIC_RELAXED, __HIP_MEMORY_SCOPE_AGENT); }
__device__ __forceinline__ unsigned xb_xcc_id() { return (unsigned)__builtin_amdgcn_s_getreg((3 << 11) | 20) & 0xFu; }
#define XB_SPIN(cond, bar) do { unsigned _sp = 0; while (cond) { __builtin_amdgcn_s_sleep(1); \
    if ((++_sp & 255u) == 0u) { if (xb_ld(&(bar)[XB_TMO])) break; if (_sp > XB_SPIN_CAP) { atomicAdd(&(bar)[XB_TMO], 1u); break; } } } } while (0)

struct XcdBarrier {
    unsigned* bar; unsigned x;
    volatile LAS unsigned* st;
};

__device__ __forceinline__ XcdBarrier xcd_barrier_post(unsigned* bar, volatile LAS unsigned* st) {
    XcdBarrier b; b.bar = bar; b.x = xb_xcc_id(); b.st = st;
    if (threadIdx.x == 0) (void)xb_add(&bar[XB_XCNT(b.x)], 1u);
    return b;
}
__device__ __forceinline__ void xcd_barrier_complete(unsigned* bar, unsigned x, unsigned& nloc, unsigned& nx) {
    const unsigned G = gridDim.x * gridDim.y * gridDim.z;
    unsigned sum, cnt, mine, sp = 0u;
    for (;;) {
        sum = 0u; cnt = 0u; mine = 0u;
#pragma unroll
        for (unsigned j = 0; j < 16; ++j) { const unsigned c = xb_ld(&bar[XB_XCNT(j)]); sum += c; cnt += (c > 0u) ? 1u : 0u; mine = (j == x) ? c : mine; }
        if (sum == G) break;
        __builtin_amdgcn_s_sleep(1);
        if ((++sp & 255u) == 0u) { if (xb_ld(&bar[XB_TMO])) break; if (sp > XB_SPIN_CAP) { atomicAdd(&bar[XB_TMO], 1u); break; } }
    }
    nloc = mine > 0u ? mine : 1u; nx = cnt > 0u ? cnt : 1u;
}

__device__ __forceinline__ void xcd_barrier(const XcdBarrier& b) {
    asm volatile("s_waitcnt vmcnt(0)" ::: "memory");
    __syncthreads();
    if (threadIdx.x == 0) {
        unsigned* bar = b.bar;
        __builtin_amdgcn_s_waitcnt(0);
        unsigned nloc = b.st[0], nx = b.st[1];
        if (nloc == 0u) { xcd_barrier_complete(bar, b.x, nloc, nx); b.st[0] = nloc; b.st[1] = nx; }
        const unsigned old = xb_add(&bar[XB_XSUB(b.x)], 1u);
        const unsigned gen = old / nloc;
        if (old + 1u == (gen + 1u) * nloc) {
            __builtin_amdgcn_fence(__ATOMIC_RELEASE, "agent");
            asm volatile("s_waitcnt vmcnt(0)" ::: "memory");
            const unsigned og = xb_add(&bar[XB_TOP], 1u);
            const unsigned tg = og / nx;
            if (og + 1u == (tg + 1u) * nx) xb_add(&bar[XB_TOPGEN], 1u);
            else XB_SPIN(xb_ld(&bar[XB_TOPGEN]) == tg, bar);
            __builtin_amdgcn_fence(__ATOMIC_ACQUIRE, "agent");
            xb_add(&bar[XB_XGEN(b.x)], 1u);
            asm volatile("s_waitcnt vmcnt(0)" ::: "memory");
        } else {
            XB_SPIN(xb_ld(&bar[XB_XGEN(b.x)]) == gen, bar);
            __builtin_amdgcn_fence(__ATOMIC_ACQUIRE, "agent");
            asm volatile("s_waitcnt vmcnt(0)" ::: "memory");
        }
    }
    __syncthreads();
}

#define grid_seam() xcd_barrier(bar)

__global__ void __launch_bounds__(512, 2) hybrid_fwd(Args args) {
    extern __shared__ __attribute__((aligned(16))) unsigned char lds_raw[];
    LAS unsigned char* lds = (LAS unsigned char*)lds_raw;

    const int tid = threadIdx.x, lane = tid & 63, wave = __builtin_amdgcn_readfirstlane(tid >> 6);
    const int G = gridDim.x, bid = blockIdx.x;
    const int gw = bid * 8 + wave, ngw = G * 8;
    unsigned char* ws = args.ws;
    if (tid < 2) ((LAS unsigned*)(lds + RING_BYTES))[tid] = 0u;
    __syncthreads();
    cg::this_grid().sync();
    XcdBarrier bar = xcd_barrier_post((unsigned*)ws, (volatile LAS unsigned*)(lds + RING_BYTES));
    const float* x = args.in[0];
    float* X = args.out;
    bf16_t* WGU1 = (bf16_t*)(ws + WS_WGU1); bf16_t* WD1 = (bf16_t*)(ws + WS_WD1); bf16_t* WGU2 = (bf16_t*)(ws + WS_WGU2); bf16_t* WD2 = (bf16_t*)(ws + WS_WD2);
    bf16_t* WIN = (bf16_t*)(ws + WS_WIN); bf16_t* WA = (bf16_t*)(ws + WS_WA); bf16_t* WM = (bf16_t*)(ws + WS_WM); bf16_t* WO = (bf16_t*)(ws + WS_WO);
    bf16_t* H = (bf16_t*)(ws + WS_H); bf16_t* ACT = (bf16_t*)(ws + WS_ACT); bf16_t* F = (bf16_t*)(ws + WS_F);
    bf16_t* Qb = (bf16_t*)(ws + WS_Q); bf16_t* ATT = (bf16_t*)(ws + WS_ATT); bf16_t* QKMV = (bf16_t*)(ws + WS_QKMV); bf16_t* HPRE = (bf16_t*)(ws + WS_HPRE);
    bf16_t* OG = (bf16_t*)(ws + WS_OG); bf16_t* Y = (bf16_t*)(ws + WS_Y);
    float* IF = (float*)(ws + WS_IF); float* LSE = (float*)(ws + WS_LSE); float* ROPE = (float*)(ws + WS_ROPE); float* GT = (float*)(ws + WS_GT); float* SSQ = (float*)(ws + WS_SSQ);

    {
        LAS float* scr = (LAS float*)(lds + wave * 16384);
        constexpr int I_G = 16 * 88, I_D = 44 * 32, I_INA = 16 * 272, I_INB = 16 * 64, I_A = 8 * 32, I_M = 16 * 32;
        constexpr int NIT = 6 * I_G + I_INA + I_INB + I_A + 2 * I_M;
        for (int it = gw; it < NIT; it += ngw) {
            int r = it;
            if (r < 4 * I_G) {
                const int w = r / I_G; r -= w * I_G; const int kb = r / 88, nb = r % 88;
                const float* src = args.in[w == 0 ? 2 : w == 1 ? 3 : w == 2 ? 18 : 19];
                tr_item(src, DFF, 32 * nb, 64 * kb, (w < 2) ? WGU1 : WGU2, 1024, 256 * (nb >> 2) + 32 * (nb & 3) + 128 * (w & 1), scr, lane); continue; }
            r -= 4 * I_G;
            if (r < 2 * I_D) {
                const int w = r / I_D; r -= w * I_D; const int kb = r / 32, nb = r % 32;
                tr_item(args.in[w == 0 ? 4 : 20], 1024, 32 * nb, 64 * kb, w == 0 ? WD1 : WD2, DFF, 32 * nb, scr, lane); continue; }
            r -= 2 * I_D;
            if (r < I_INA) { const int kb = r / 272, nb = r % 272; tr_item(args.in[7], INW, 32 * nb, 64 * kb, WIN, 1024, 32 * nb, scr, lane); continue; }
            r -= I_INA;
            if (r < I_INB) { const int kb = r / 64, nb = r % 64; tr_item(args.in[7], INW, 8712 + 32 * nb, 64 * kb, WIN, 1024, 8704 + 32 * nb, scr, lane); continue; }
            r -= I_INB;
            if (r < I_A) { const int kb = r / 32, nb = r % 32; tr_item(args.in[13], 1024, 32 * nb, 64 * kb, WA, 512, 32 * nb, scr, lane); continue; }
            r -= I_A;
            if (r < I_M) { const int kb = r / 32, nb = r % 32; tr_item(args.in[14], 1024, 32 * nb, 64 * kb, WM, 1024, 32 * nb, scr, lane); continue; }
            r -= I_M;
            { const int kb = r / 32, nb = r % 32; tr_item(args.in[15], 1024, 32 * nb, 64 * kb, WO, 1024, 32 * nb, scr, lane); }
        }
        for (int id = bid * 512 + tid; id < 2048 * 16; id += G * 512) {
            const int pos = id >> 4, i = id & 15;
            const float invf = powf(500000.0f, -((float)i * 2.0f / 32.0f));
            const float ang = (float)pos * invf;
            const double a = (double)ang; const double k = rint(a * 0.15915494309189535); const float rr = (float)(a - k * 6.283185307179586);
            ROPE[2 * id] = cosf(rr); ROPE[2 * id + 1] = sinf(rr);
        }
        for (int i = bid * 512 + tid; i < M * 4; i += G * 512) SSQ[i] = 0.f;
        rowpass<false, false, true, false>(gw, ngw, lane, x, nullptr, 0.f, nullptr, nullptr, args.in[1], H, nullptr, nullptr);
    }
    grid_seam();
    { pg8::Gemm g{H, WGU1, M, 5632, 1024}; pg8::StaticOrder S; S.init(M, 5632, G, bid); pg8::Epi<1> E{ACT, DFF, nullptr, 0, 0, nullptr, 1.f, 0};
      pg8::gemm_phase<pg8::Epi<1>, pg8::StaticOrder, true, true>(lds, g, S, E); }
    grid_seam();
    { pg8::Gemm g{ACT, WD1, M, 1024, DFF}; pg8::StaticOrder S; S.init(M, 1024, G, bid); pg8::Epi<0> E{F, 1024, nullptr, 0, 0, nullptr, 1.f, 0};
      pg8::gemm_phase<pg8::Epi<0>, pg8::StaticOrder, true, true>(lds, g, S, E); }
    grid_seam();
    {
        LAS f32x4* wif = (LAS f32x4*)lds;
        const float* win = args.in[7];
        for (int i = tid; i < 32 * 64; i += 512) { const int ln = i & 63, q = i >> 6, half = q & 1, e = (q >> 1) & 3, j = q >> 3; const int k = 4 * ln + e + 256 * j;
            const float* p = win + (size_t)k * INW + 8704 + 4 * half; wif[i] = (f32x4){p[0], p[1], p[2], p[3]}; }
        __syncthreads();
        rowpass<true, true, true, true>(gw, ngw, lane, x, F, 0.5f, args.in[5], X, args.in[6], H, wif, IF);
        __syncthreads();
    }
    grid_seam();
    { pg8::Gemm g{H, WIN, M, 4608, 1024}; pg8::StaticOrder S; S.init(M, 4608, G, bid);
      pg8::Epi<3> E{Qb, 1536, nullptr, 0, 0, ROPE, 0.08838834764831845f * 1.4426950408889634f, (size_t)M * 1536};
      pg8::gemm_phase<pg8::Epi<3>, pg8::StaticOrder, true, true>(lds, g, S, E); }
    if (bid >= G - 32) gates_prepass(lds, IF, args.in[10], args.in[11], GT, bid - (G - 32), tid, wave, lane);
    grid_seam();
    for (int it = bid; it < 1536; it += G) attn_item(lds, Qb, Qb + (size_t)M * 1536, Qb + (size_t)2 * M * 1536, LSE, it, tid, wave, lane);
    grid_seam();
    for (int row = gw; row < M; row += ngw) {
        const int slot = lane >> 4;
        const float l0 = LSE[(size_t)row * 12 + slot], l1 = LSE[(size_t)row * 12 + 4 + slot], l2 = LSE[(size_t)row * 12 + 8 + slot];
        const float mx = fmaxf(l0, fmaxf(l1, l2));
        float e0 = __expf(l0 - mx), e1 = __expf(l1 - mx), e2 = __expf(l2 - mx); const float inv = 1.0f / (e0 + e1 + e2); e0 *= inv; e1 *= inv; e2 *= inv;
        f32x4 a0, a1, b0, b1, c0, c1;
        pg8::load8(Qb + (size_t)row * 1536 + 8 * lane, a0, a1); pg8::load8(Qb + (size_t)row * 1536 + 512 + 8 * lane, b0, b1); pg8::load8(Qb + (size_t)row * 1536 + 1024 + 8 * lane, c0, c1);
        pg8::store8(ATT + (size_t)row * 512 + 8 * lane, a0 * e0 + b0 * e1 + c0 * e2, a1 * e0 + b1 * e1 + c1 * e2);
    }
    { pg8::Gemm g{H, WIN + (size_t)4608 * 1024, M, 3072, 1024}; pg8::StaticOrder S; S.init(M, 3072, G, bid); pg8::Epi<0> E{QKMV, 3072, nullptr, 0, 0, nullptr, 1.f, 0};
      pg8::gemm_phase<pg8::Epi<0>, pg8::StaticOrder, true, true>(lds, g, S, E); }
    grid_seam();
    { ConvHalo CH; conv_halo(QKMV, bid * 512 + tid, CH); grid_seam(); conv_run(QKMV, args.in[8], args.in[9], bid * 512 + tid, CH); }
    grid_seam();
    for (int it = bid; it < 256; it += G) mlstm_item(lds, QKMV, GT, HPRE, SSQ, it, tid, wave, lane);
    grid_seam();
    { pg8::Gemm g{H, WIN + (size_t)7680 * 1024, M, 3072, 1024}; pg8::StaticOrder S; S.init(M, 3072, G, bid); pg8::Epi<6> E{OG, 3072, nullptr, 0, 0, nullptr, 1.f, 0, HPRE, SSQ, args.in[12]};
      pg8::gemm_phase<pg8::Epi<6>, pg8::StaticOrder, true, true>(lds, g, S, E); }
    grid_seam();
    { pg8::Gemm g{ATT, WA, M, 1024, 512}; pg8::StaticOrder S; S.init(M, 1024, G, bid); pg8::Epi<4> E{H, 1024, OG, 3072, 1024, nullptr, 1.f, 0};
      pg8::gemm_phase<pg8::Epi<4>, pg8::StaticOrder, true, true>(lds, g, S, E); }
    { pg8::Gemm g{HPRE, WM, M, 1024, 1024}; pg8::StaticOrder S; S.init(M, 1024, G, bid); pg8::Epi<5> E{H, 1024, OG, 3072, 2048, nullptr, 1.f, 0};
      pg8::gemm_phase<pg8::Epi<5>, pg8::StaticOrder, true, true>(lds, g, S, E); }
    grid_seam();
    { pg8::Gemm g{H, WO, M, 1024, 1024}; pg8::StaticOrder S; S.init(M, 1024, G, bid); pg8::Epi<0> E{Y, 1024, nullptr, 0, 0, nullptr, 1.f, 0};
      pg8::gemm_phase<pg8::Epi<0>, pg8::StaticOrder, true, true>(lds, g, S, E); }
    grid_seam();
    rowpass<true, true, true, false>(gw, ngw, lane, X, Y, 1.0f, args.in[16], X, args.in[17], H, nullptr, nullptr);
    grid_seam();
    { pg8::Gemm g{H, WGU2, M, 5632, 1024}; pg8::StaticOrder S; S.init(M, 5632, G, bid); pg8::Epi<1> E{ACT, DFF, nullptr, 0, 0, nullptr, 1.f, 0};
      pg8::gemm_phase<pg8::Epi<1>, pg8::StaticOrder, true, true>(lds, g, S, E); }
    grid_seam();
    { pg8::Gemm g{ACT, WD2, M, 1024, DFF}; pg8::StaticOrder S; S.init(M, 1024, G, bid); pg8::Epi<0> E{F, 1024, nullptr, 0, 0, nullptr, 1.f, 0};
      pg8::gemm_phase<pg8::Epi<0>, pg8::StaticOrder, true, true>(lds, g, S, E); }
    grid_seam();
    rowpass<true, true, false, false>(gw, ngw, lane, X, F, 0.5f, args.in[21], X, nullptr, nullptr, nullptr, nullptr);
}

extern "C" void kernel_launch(void* const* d_in, const int* in_sizes, int n_in, void* d_out, int out_size, void* d_ws, size_t ws_size, hipStream_t stream) {
    static int grid = 0;
    if (grid == 0) {
        if (n_in != 22 || out_size != M * DM || ws_size < WS_END) { fprintf(stderr, "kernel_launch: unexpected shapes (n_in %d out %d ws %zu)\n", n_in, out_size, ws_size); grid = -1; return; }
        int dev = 0, cus = 0, per_cu = 0;
        hipGetDevice(&dev);
        hipDeviceGetAttribute(&cus, hipDeviceAttributeMultiprocessorCount, dev);
        if (hipFuncSetAttribute((const void*)hybrid_fwd, hipFuncAttributeMaxDynamicSharedMemorySize, LDS_BYTES) != hipSuccess) { fprintf(stderr, "kernel_launch: hipFuncSetAttribute failed\n"); grid = -1; return; }
        if (hipOccupancyMaxActiveBlocksPerMultiprocessor(&per_cu, (const void*)hybrid_fwd, 512, LDS_BYTES) != hipSuccess || per_cu < 1) { fprintf(stderr, "kernel_launch: occupancy query says %d\n", per_cu); per_cu = 1; }
        (void)hipGetLastError();
        grid = cus;
        if (grid > 256) grid = 256;
    }
    if (grid < 0) return;
    Args a{};
    for (int i = 0; i < 22; ++i) a.in[i] = (const float*)d_in[i];
    a.out = (float*)d_out; a.ws = (unsigned char*)d_ws;
    if (hipMemsetAsync(d_ws, 0, 16384, stream) != hipSuccess) { fprintf(stderr, "memset failed\n"); return; }
    void* kargs[] = {&a};
    hipError_t e = hipLaunchCooperativeKernel((const void*)hybrid_fwd, dim3(grid), dim3(512), kargs, LDS_BYTES, stream);
    if (e != hipSuccess) fprintf(stderr, "cooperative launch failed: %s (grid %d)\n", hipGetErrorString(e), grid);
}
```

```cpp
#define MLV 1
#include <hip/hip_runtime.h>
#include <hip/hip_cooperative_groups.h>
#include <cstdio>
#include <cstdint>
namespace cg = cooperative_groups;
namespace pg8 {
#define PG8_LAS __attribute__((address_space(3)))
typedef unsigned short bf16_t;
typedef short bf16x8 __attribute__((ext_vector_type(8)));
typedef float f32x4 __attribute__((ext_vector_type(4)));
typedef unsigned u32x4 __attribute__((ext_vector_type(4)));
constexpr int BM = 256, BK = 64, HALF = 128, HTB = HALF * BK * 2  , STAGE_BYTES = 8 * HTB, NXCD = 8, WGM = 8;

__host__ __device__ __forceinline__ int lds_byte(int r, int c) { const int st = (r >> 4) * 2 + (c >> 5), rr = r & 15, cc = c & 31, ob = rr * 64 + cc * 2; return st * 1024 + (ob ^ (((ob >> 9) & 1) << 5)); }
__host__ __device__ __forceinline__ void stage_rc(int b, int& R, int& C) { const int st = b / 1024, sb = b % 1024, swz = sb ^ (((sb >> 9) & 1) << 5); R = (st >> 1) * 16 + swz / 64; C = (st & 1) * 32 + (swz % 64) / 2; }
__host__ __device__ __forceinline__ int perm32(int rho) { const int n = rho >> 4, i = rho & 15; return 8 * (i >> 2) + 4 * n + (i & 3); }

struct Unit { int pm, pn; };
struct Gemm { const bf16_t* A; const bf16_t* Bt; int M, N, K; };

struct StaticOrder {
    int nM, nN, nwg, G, c;
    __host__ __device__ void init(int M, int N, int G_, int c_) { nM = M / BM; nN = N / BM; nwg = nM * nN; G = G_; c = c_; }
    __host__ __device__ bool next(int i, Unit& u) const {
        const long L = (long)i * G + c; if (L >= nwg) return false;
        int wgid = (int)L; { const int q = nwg / NXCD, r = nwg % NXCD, xcd = wgid % NXCD, off = wgid / NXCD; wgid = (xcd < r ? xcd * (q + 1) : r * (q + 1) + (xcd - r) * q) + off; }
        const int nig = WGM * nN, gid = wgid / nig, fm = gid * WGM, gsz = (nM - fm) < WGM ? (nM - fm) : WGM;
        u.pm = fm + ((wgid % nig) % gsz); u.pn = (wgid % nig) / gsz; return true;
    }
    __device__ __forceinline__ void a_ready(const Unit&) const {}
    __device__ __forceinline__ void done(const Unit&) const {}
};

typedef float f32x2c_t __attribute__((ext_vector_type(2))); typedef __bf16 bf16x2c_t __attribute__((ext_vector_type(2)));
__device__ __forceinline__ unsigned cvt_pk_bf16(float lo, float hi) { const f32x2c_t v = {lo, hi}; const bf16x2c_t b = __builtin_convertvector(v, bf16x2c_t); return __builtin_bit_cast(unsigned, b); }
typedef float f32x2 __attribute__((ext_vector_type(2)));
typedef unsigned u32x2 __attribute__((ext_vector_type(2)));
__device__ __forceinline__ float sigmoidf_(float x) { return __builtin_amdgcn_rcpf(1.0f + __expf(-x)); }
__device__ __forceinline__ void store8(bf16_t* p, const f32x4 v0, const f32x4 v1) {
    u32x4 w; w.x = cvt_pk_bf16(v0[0], v0[1]); w.y = cvt_pk_bf16(v0[2], v0[3]); w.z = cvt_pk_bf16(v1[0], v1[1]); w.w = cvt_pk_bf16(v1[2], v1[3]); *(u32x4*)p = w;
}
__device__ __forceinline__ void load8(const bf16_t* p, f32x4& v0, f32x4& v1) {
    const u32x4 w = *(const u32x4*)p;
    v0[0] = __uint_as_float(w.x << 16); v0[1] = __uint_as_float(w.x & 0xffff0000u); v0[2] = __uint_as_float(w.y << 16); v0[3] = __uint_as_float(w.y & 0xffff0000u);
    v1[0] = __uint_as_float(w.z << 16); v1[1] = __uint_as_float(w.z & 0xffff0000u); v1[2] = __uint_as_float(w.w << 16); v1[3] = __uint_as_float(w.w & 0xffff0000u);
}
__device__ __forceinline__ void unpack8(const u32x4 w, f32x4& v0, f32x4& v1) {
    v0[0] = __uint_as_float(w.x << 16); v0[1] = __uint_as_float(w.x & 0xffff0000u); v0[2] = __uint_as_float(w.y << 16); v0[3] = __uint_as_float(w.y & 0xffff0000u);
    v1[0] = __uint_as_float(w.z << 16); v1[1] = __uint_as_float(w.z & 0xffff0000u); v1[2] = __uint_as_float(w.w << 16); v1[3] = __uint_as_float(w.w & 0xffff0000u);
}
template <int MODE> struct Epi {
    static constexpr bool PERM = true, AFTER_DRAIN = false;
    bf16_t* O; int ldc; const bf16_t* G; int ldg; int gcol; const float* rope; float qscale; size_t split_stride;
    bf16_t* HP; const float* ssq; const float* hg;
    __device__ __forceinline__ void operator()(const f32x4 (&acc)[2][2][4][2], const Unit& u, int wr, int wc, int fr, int fq) const {
        const int row0 = u.pm * BM + wr * 64 + fr;
        if constexpr (MODE == 1) {
            const int col0 = u.pn * HALF + wc * 32 + 8 * fq;
#pragma unroll
            for (int ai = 0; ai < 2; ++ai)
#pragma unroll
                for (int m = 0; m < 4; ++m) {
                    f32x4 o[2];
#pragma unroll
                    for (int n = 0; n < 2; ++n)
#pragma unroll
                        for (int i = 0; i < 4; ++i) { const float g = acc[ai][0][m][n][i], up = acc[ai][1][m][n][i]; o[n][i] = g * sigmoidf_(g) * up; }
                    store8(O + (size_t)(row0 + ai * HALF + m * 16) * ldc + col0, o[0], o[1]);
                }
        } else if constexpr (MODE == 3) {
            const int colt = u.pn * BM; const int t = colt / 1536;
            bf16_t* base = O + (size_t)t * split_stride;
            const int lc = colt - t * 1536 + wc * 32 + 8 * fq;
            const bool rp = (t < 2) && (wc == 0);
            const float sc = (t == 0) ? qscale : 1.0f;
            const float sgn = (fq < 2) ? -1.0f : 1.0f;
            float rf[2][4];
#pragma unroll
            for (int n = 0; n < 2; ++n)
#pragma unroll
                for (int i = 0; i < 4; ++i) rf[n][i] = __builtin_amdgcn_exp2f(-(float)(8 * (fq & 1) + 4 * n + i) * (18.931568569324174f / 16.0f)) * 0.15915494309189535f;
#pragma unroll
            for (int ai = 0; ai < 2; ++ai)
#pragma unroll
                for (int m = 0; m < 4; ++m) {
                    const int row = row0 + ai * HALF + m * 16;
                    f32x4 cs[2][2];
                    if (rp) {
                        const float pos = (float)(row & 2047);
#pragma unroll
                        for (int n = 0; n < 2; ++n)
#pragma unroll
                            for (int i = 0; i < 4; ++i) { const float rv = __builtin_amdgcn_fractf(pos * rf[n][i]); cs[n][i >> 1][2 * (i & 1)] = __builtin_amdgcn_cosf(rv); cs[n][i >> 1][2 * (i & 1) + 1] = __builtin_amdgcn_sinf(rv); }
                    }
#pragma unroll
                    for (int bj = 0; bj < 2; ++bj) {
                        f32x4 o[2];
#pragma unroll
                        for (int n = 0; n < 2; ++n) {
                            f32x4 v = acc[ai][bj][m][n];
                            if (rp) {
                                f32x4 pz;
#pragma unroll
                                for (int i = 0; i < 4; ++i) { const unsigned own = __float_as_uint(v[i]); auto sw = __builtin_amdgcn_permlane32_swap(own, own, false, false);
                                    pz[i] = __uint_as_float(sw[0] ^ sw[1] ^ own); }
                                v[0] = v[0] * cs[n][0][0] + sgn * pz[0] * cs[n][0][1];
                                v[1] = v[1] * cs[n][0][2] + sgn * pz[1] * cs[n][0][3];
                                v[2] = v[2] * cs[n][1][0] + sgn * pz[2] * cs[n][1][1];
                                v[3] = v[3] * cs[n][1][2] + sgn * pz[3] * cs[n][1][3];
                            }
                            o[n] = v * sc;
                        }
                        store8(base + (size_t)row * ldc + lc + bj * HALF, o[0], o[1]);
                    }
                }
        } else {
            const int col0 = u.pn * BM + wc * 32 + 8 * fq;
            const bool ml_tile = (MODE == 6) && (u.pn < 4);
            f32x4 hgv[2][2];
            if constexpr (MODE == 6) { if (ml_tile) {
#pragma unroll
                for (int bj = 0; bj < 2; ++bj) { hgv[bj][0] = *(const f32x4*)(hg + col0 + bj * HALF); hgv[bj][1] = *(const f32x4*)(hg + col0 + bj * HALF + 4); } } }
#pragma unroll
            for (int ai = 0; ai < 2; ++ai) {
                u32x4 gq[4][2], tq[4][2]; float rs[4];
#pragma unroll
                for (int m = 0; m < 4; ++m) {
                    const int row = row0 + ai * HALF + m * 16;
                    if constexpr (MODE == 6) { if (ml_tile) rs[m] = ssq[(size_t)row * 4 + u.pn]; }
#pragma unroll
                    for (int bj = 0; bj < 2; ++bj) {
                        if constexpr (MODE == 4 || MODE == 5) gq[m][bj] = *(const u32x4*)(G + (size_t)row * ldg + gcol + col0 + bj * HALF);
                        if constexpr (MODE == 5) tq[m][bj] = *(const u32x4*)(O + (size_t)row * ldc + col0 + bj * HALF);
                        if constexpr (MODE == 6) { if (ml_tile) tq[m][bj] = *(const u32x4*)(HP + (size_t)row * 1024 + col0 + bj * HALF); }
                    }
                }
#pragma unroll
                for (int m = 0; m < 4; ++m) {
                    const int row = row0 + ai * HALF + m * 16;
#pragma unroll
                    for (int bj = 0; bj < 2; ++bj) {
                        f32x4 v0 = acc[ai][bj][m][0], v1 = acc[ai][bj][m][1];
                        bf16_t* op = O + (size_t)row * ldc + col0 + bj * HALF;
                        if constexpr (MODE == 2 || MODE == 6) {
#pragma unroll
                            for (int i = 0; i < 4; ++i) { v0[i] = sigmoidf_(v0[i]); v1[i] = sigmoidf_(v1[i]); }
                        }
                        if constexpr (MODE == 6) {
                            if (ml_tile) {
                                const float rstd = __builtin_amdgcn_rsqf(rs[m] * (1.0f / 256.0f) + 1e-6f);
                                f32x4 h0, h1; unpack8(tq[m][bj], h0, h1);
                                store8(HP + (size_t)row * 1024 + col0 + bj * HALF, v0 * h0 * hgv[bj][0] * rstd, v1 * h1 * hgv[bj][1] * rstd);
                                continue;
                            }
                        }
                        if constexpr (MODE == 4 || MODE == 5) {
                            f32x4 g0, g1; unpack8(gq[m][bj], g0, g1);
                            v0 = v0 * g0; v1 = v1 * g1;
                            if constexpr (MODE == 5) { f32x4 t0, t1; unpack8(tq[m][bj], t0, t1); v0 = v0 + t0; v1 = v1 + t1; }
                        }
                        store8(op, v0, v1);
                    }
                }
            }
        }
    }
};
template <class Epi, class Sched, bool ALIGN_EPI = false, bool SP2 = false>
__device__ __forceinline__ void gemm_phase(PG8_LAS unsigned char* lds, const Gemm g, const Sched& S, const Epi& E) {
    int tid_l = threadIdx.x; asm volatile("" : "+v"(tid_l));
    const int tid = tid_l, wid = __builtin_amdgcn_readfirstlane(tid >> 6), lane = tid & 63, wr = wid >> 2, wc = wid & 3, fr = lane & 15, fq = lane >> 4;
    const int K = g.K, nt = K / BK;
    unsigned voffA[2], voffB[2];
#pragma unroll
    for (int i = 0; i < 2; ++i) { int R, C; stage_rc(tid * 16 + i * 8192, R, C); const int Rb = Epi::PERM ? ((R & ~31) + perm32(R & 31)) : R;
        voffA[i] = (unsigned)(R * K + C) * 2u; voffB[i] = (unsigned)(Rb * K + C) * 2u; }
    const size_t kstep = (size_t)(BK * 2);
    const size_t hstep = (size_t)HALF * K * 2;
    const size_t tstep = 2 * hstep;
    const unsigned ldsw = (unsigned)wid * 1024u;
    const int aoff = lds_byte(wr * 64 + fr, fq * 8), boff = lds_byte(wc * 32 + fr, fq * 8);
#define PG8_SA(b, h) (((b) * 2 + (h)) * HTB)
#define PG8_SB(b, h) ((4 + (b) * 2 + (h)) * HTB)
#define PG8_STAGE(bufoff, gbase, voff) do { _Pragma("unroll") for (int _i = 0; _i < 2; ++_i) \
        __builtin_amdgcn_global_load_lds((const unsigned*)((const char*)(gbase) + (voff)[_i]), (PG8_LAS unsigned*)(lds + (bufoff) + ldsw + _i * 8192), 16, 0, 0); } while (0)
#define PG8_LDA(dst, b, h) do { _Pragma("unroll") for (int m = 0; m < 4; ++m) _Pragma("unroll") for (int k = 0; k < 2; ++k) dst[m][k] = *(const PG8_LAS bf16x8*)(lds + PG8_SA(b, h) + aoff + m * 2048 + k * 1024); } while (0)
#define PG8_LDB(dst, b, h) do { _Pragma("unroll") for (int n = 0; n < 2; ++n) _Pragma("unroll") for (int k = 0; k < 2; ++k) dst[n][k] = *(const PG8_LAS bf16x8*)(lds + PG8_SB(b, h) + boff + n * 2048 + k * 1024); } while (0)
#define PG8_MMA(ai, bj, At, Bt) do { __builtin_amdgcn_s_setprio(1); _Pragma("unroll") for (int m = 0; m < 4; ++m) _Pragma("unroll") for (int n = 0; n < 2; ++n) _Pragma("unroll") for (int k = 0; k < 2; ++k) \
        acc[ai][bj][m][n] = __builtin_amdgcn_mfma_f32_16x16x32_bf16(Bt[n][k], At[m][k], acc[ai][bj][m][n], 0, 0, 0); __builtin_amdgcn_s_setprio(0); } while (0)
#define PG8_WAIT_V(n) asm volatile("s_waitcnt vmcnt(" #n ")" ::: "memory")
#define PG8_WAIT_L(n) asm volatile("s_waitcnt lgkmcnt(" #n ")" ::: "memory")
#define PG8_BAR __builtin_amdgcn_s_barrier()
#define PG8_SCHED __builtin_amdgcn_sched_barrier(0)
    Unit cur, nxt; int ui = 0;
    if (!S.next(0, cur)) return;
    f32x4 acc[2][2][4][2];
#pragma unroll
    for (int a = 0; a < 2; ++a)
#pragma unroll
        for (int b = 0; b < 2; ++b)
#pragma unroll
            for (int m = 0; m < 4; ++m)
#pragma unroll
                for (int n = 0; n < 2; ++n) acc[a][b][m][n] = (f32x4){0.f, 0.f, 0.f, 0.f};
    bf16x8 At[4][2], B0[2][2], B1[2][2];
    const char* cA = (const char*)g.A + (size_t)cur.pm * tstep; const char* cB = (const char*)g.Bt + (size_t)cur.pn * tstep;
    S.a_ready(cur);
    if constexpr (SP2) {
        PG8_STAGE(PG8_SB(0, 0), cB, voffB); PG8_STAGE(PG8_SB(0, 1), cB + hstep, voffB); PG8_STAGE(PG8_SA(0, 0), cA, voffA); PG8_STAGE(PG8_SA(0, 1), cA + hstep, voffA);
        if (wr == 1) PG8_BAR;
        PG8_WAIT_V(2); PG8_BAR;
        PG8_STAGE(PG8_SB(1, 0), cB + kstep, voffB); PG8_STAGE(PG8_SA(1, 0), cA + kstep, voffA); PG8_STAGE(PG8_SB(1, 1), cB + hstep + kstep, voffB);
        PG8_WAIT_V(6); PG8_BAR;
    } else {
        PG8_STAGE(PG8_SB(0, 0), cB, voffB); PG8_STAGE(PG8_SA(0, 0), cA, voffA); PG8_STAGE(PG8_SB(0, 1), cB + hstep, voffB); PG8_STAGE(PG8_SA(0, 1), cA + hstep, voffA);
        if (wr == 1) PG8_BAR;
        PG8_WAIT_V(4); PG8_BAR;
        PG8_STAGE(PG8_SB(1, 0), cB + kstep, voffB); PG8_STAGE(PG8_SA(1, 0), cA + kstep, voffA); PG8_STAGE(PG8_SB(1, 1), cB + hstep + kstep, voffB);
        PG8_WAIT_V(6); PG8_BAR;
    }
    for (;;) {
        const bool has_next = S.next(ui + 1, nxt);
        const char* nA = has_next ? (const char*)g.A + (size_t)nxt.pm * tstep : cA; const char* nB = has_next ? (const char*)g.Bt + (size_t)nxt.pn * tstep : cB;
        for (int t = 0; t < nt; t += 2) {
            const bool last = (t == nt - 2);
            const char* a1 = cA + (size_t)(t + 1) * kstep;
            const char* a2 = last ? nA : cA + (size_t)(t + 2) * kstep; const char* b2 = last ? nB : cB + (size_t)(t + 2) * kstep;
            const char* a3 = a2 + kstep; const char* b3 = b2 + kstep;
            if (last && has_next) S.a_ready(nxt);
            if constexpr (SP2) {
            PG8_LDB(B0, 0, 0); PG8_LDB(B1, 0, 1); PG8_SCHED; PG8_LDA(At, 0, 0); PG8_STAGE(PG8_SA(1, 1), a1 + hstep, voffA);
            PG8_WAIT_V(8); PG8_WAIT_L(0); PG8_BAR; PG8_MMA(0, 0, At, B0); PG8_MMA(0, 1, At, B1); PG8_BAR; PG8_SCHED;
            PG8_LDA(At, 0, 1); PG8_STAGE(PG8_SB(0, 0), b2, voffB); PG8_STAGE(PG8_SB(0, 1), b2 + hstep, voffB); PG8_STAGE(PG8_SA(0, 0), a2, voffA);
            PG8_WAIT_V(8); PG8_WAIT_L(0); PG8_BAR; PG8_MMA(1, 0, At, B0); PG8_MMA(1, 1, At, B1); PG8_BAR; PG8_SCHED;
            PG8_LDB(B0, 1, 0); PG8_LDB(B1, 1, 1); PG8_SCHED; PG8_LDA(At, 1, 0); PG8_STAGE(PG8_SA(0, 1), a2 + hstep, voffA);
            PG8_WAIT_V(8); PG8_WAIT_L(0); PG8_BAR; PG8_MMA(0, 0, At, B0); PG8_MMA(0, 1, At, B1); PG8_BAR; PG8_SCHED;
            PG8_LDA(At, 1, 1); PG8_STAGE(PG8_SB(1, 0), b3, voffB); PG8_STAGE(PG8_SB(1, 1), b3 + hstep, voffB); PG8_STAGE(PG8_SA(1, 0), a3, voffA);
            PG8_WAIT_V(8); PG8_WAIT_L(0); PG8_BAR; PG8_MMA(1, 0, At, B0); PG8_MMA(1, 1, At, B1); PG8_BAR; PG8_SCHED;
            } else {
            PG8_LDB(B0, 0, 0); PG8_SCHED; PG8_LDA(At, 0, 0); PG8_STAGE(PG8_SA(1, 1), a1 + hstep, voffA);
            PG8_WAIT_L(8); PG8_BAR; PG8_WAIT_L(0); PG8_MMA(0, 0, At, B0); PG8_BAR; PG8_SCHED;
            PG8_LDB(B1, 0, 1); PG8_STAGE(PG8_SB(0, 0), b2, voffB);
            PG8_BAR; PG8_WAIT_L(0); PG8_MMA(0, 1, At, B1); PG8_BAR;
            PG8_LDA(At, 0, 1); PG8_STAGE(PG8_SA(0, 0), a2, voffA);
            PG8_BAR; PG8_WAIT_L(0); PG8_MMA(1, 0, At, B0); PG8_BAR; PG8_SCHED;
            PG8_STAGE(PG8_SB(0, 1), b2 + hstep, voffB);
            PG8_WAIT_V(6); PG8_BAR; PG8_MMA(1, 1, At, B1); PG8_BAR;
            PG8_LDB(B0, 1, 0); PG8_SCHED; PG8_LDA(At, 1, 0); PG8_STAGE(PG8_SA(0, 1), a2 + hstep, voffA);
            PG8_WAIT_L(8); PG8_BAR; PG8_WAIT_L(0); PG8_MMA(0, 0, At, B0); PG8_BAR; PG8_SCHED;
            PG8_LDB(B1, 1, 1); PG8_STAGE(PG8_SB(1, 0), b3, voffB);
            PG8_BAR; PG8_WAIT_L(0); PG8_MMA(0, 1, At, B1); PG8_BAR;
            PG8_LDA(At, 1, 1); PG8_STAGE(PG8_SA(1, 0), a3, voffA);
            PG8_BAR; PG8_WAIT_L(0); PG8_MMA(1, 0, At, B0); PG8_BAR; PG8_SCHED;
            PG8_STAGE(PG8_SB(1, 1), b3 + hstep, voffB);
            PG8_WAIT_V(6); PG8_BAR; PG8_MMA(1, 1, At, B1); PG8_BAR;
            }
        }
        if constexpr (ALIGN_EPI) { if (wr == 0) PG8_BAR; }
        if constexpr (!Epi::AFTER_DRAIN) { E(acc, cur, wr, wc, fr, fq); S.done(cur); }
        if (!has_next) break;
#pragma unroll
        for (int a = 0; a < 2; ++a)
#pragma unroll
            for (int b = 0; b < 2; ++b)
#pragma unroll
                for (int m = 0; m < 4; ++m)
#pragma unroll
                    for (int n = 0; n < 2; ++n) acc[a][b][m][n] = (f32x4){0.f, 0.f, 0.f, 0.f};
        cur = nxt; cA = nA; cB = nB; ++ui;
        if constexpr (ALIGN_EPI) { if (wr == 1) PG8_BAR; }
    }
    PG8_WAIT_V(0);
    if constexpr (!ALIGN_EPI) { if (wr == 0) PG8_BAR; }
    PG8_BAR;
    if constexpr (Epi::AFTER_DRAIN) { E.fused(acc, cur, wr, wc, fr, fq, lds, wid, lane); S.done(cur); }
#undef PG8_SA
#undef PG8_SB
#undef PG8_STAGE
#undef PG8_LDA
#undef PG8_LDB
#undef PG8_MMA
#undef PG8_WAIT_V
#undef PG8_WAIT_L
#undef PG8_BAR
#undef PG8_SCHED
}
}

using pg8::bf16_t; using pg8::bf16x8; using pg8::f32x4; using pg8::u32x4; using pg8::u32x2; using pg8::cvt_pk_bf16;
#define LAS __attribute__((address_space(3)))
typedef short s16x4 __attribute__((ext_vector_type(4)));
constexpr int DM = 1024, BATCH = 8, SEQ = 2048, M = BATCH * SEQ, DFF = 2816, INW = 10760;
constexpr float EPS = 1e-6f;
constexpr size_t MiB = 1u << 20;
constexpr size_t WS_SSQ = 256 * 1024;
constexpr size_t WS_IF = 1 * MiB;
constexpr size_t WS_LSE = WS_IF + 512 * 1024;
constexpr size_t WS_ROPE = WS_LSE + 768 * 1024;
constexpr size_t WS_GT = WS_ROPE + 256 * 1024;
constexpr size_t WS_WGU1 = 4 * MiB;
constexpr size_t WS_WD1 = WS_WGU1 + (size_t)5632 * 1024 * 2;
constexpr size_t WS_WGU2 = WS_WD1 + (size_t)1024 * 2816 * 2;
constexpr size_t WS_WD2 = WS_WGU2 + (size_t)5632 * 1024 * 2;
constexpr size_t WS_WIN = WS_WD2 + (size_t)1024 * 2816 * 2;
constexpr size_t WS_WA = WS_WIN + (size_t)10752 * 1024 * 2;
constexpr size_t WS_WM = WS_WA + (size_t)1024 * 512 * 2;
constexpr size_t WS_WO = WS_WM + (size_t)1024 * 1024 * 2;
constexpr size_t WS_WEND = WS_WO + (size_t)1024 * 1024 * 2;
static_assert(WS_WEND <= 63 * MiB, "weights");
constexpr size_t WS_H = 63 * MiB;
constexpr size_t WS_ACT = 95 * MiB;
constexpr size_t WS_F = 183 * MiB;
constexpr size_t WS_Q = 95 * MiB;
constexpr size_t WS_ATT = 239 * MiB;
constexpr size_t WS_QKMV = 143 * MiB;
constexpr size_t WS_HPRE = 95 * MiB;
constexpr size_t WS_OG = 143 * MiB;
constexpr size_t WS_Y = 143 * MiB;
constexpr size_t WS_END = 256 * MiB;
constexpr int LDS_BYTES = 147456, RING_BYTES = 131072;

struct Args {
    const float* in[22]; float* out; unsigned char* ws;
};

__device__ __forceinline__ float wave_sum(float v) {
#pragma unroll
    for (int o = 1; o < 64; o <<= 1) v += __shfl_xor(v, o);
    return v;
}
__device__ __forceinline__ float wave_max(float v) {
#pragma unroll
    for (int o = 1; o < 64; o <<= 1) v = fmaxf(v, __shfl_xor(v, o));
    return v;
}
__device__ __forceinline__ unsigned f2bf(float f) { unsigned u = __float_as_uint(f); return (u + 0x7fffu + ((u >> 16) & 1u)) >> 16; }
__device__ __forceinline__ unsigned pk2(float lo, float hi) { return cvt_pk_bf16(lo, hi); }
__device__ __forceinline__ float bf_lo(unsigned w) { return __uint_as_float(w << 16); }
__device__ __forceinline__ float bf_hi(unsigned w) { return __uint_as_float(w & 0xffff0000u); }
__device__ __forceinline__ s16x4 vtr(const LAS unsigned char* p) { typedef short v4i16_t __attribute__((ext_vector_type(4))); return __builtin_bit_cast(s16x4, __builtin_amdgcn_ds_read_tr16_b64_v4i16((LAS v4i16_t*)p)); }
__device__ __forceinline__ bf16x8 cat8(s16x4 a, s16x4 b) { return (bf16x8){a[0], a[1], a[2], a[3], b[0], b[1], b[2], b[3]}; }
#define MFMA16(a, b, c) __builtin_amdgcn_mfma_f32_16x16x32_bf16((a), (b), (c), 0, 0, 0)

__device__ __forceinline__ void tr_item(const float* W, int ldw, int col0, int k0, bf16_t* WT, int K, int drow0, LAS float* scr, int lane) {
    const int r8 = lane >> 3, c4 = lane & 7;
    f32x4 v[8];
#pragma unroll
    for (int i = 0; i < 8; ++i) v[i] = *(const f32x4*)(W + (size_t)(k0 + r8 + 8 * i) * ldw + col0 + 4 * c4);
#pragma unroll
    for (int i = 0; i < 8; ++i) { LAS float* d = scr + (r8 + 8 * i) * 33 + 4 * c4; d[0] = v[i][0]; d[1] = v[i][1]; d[2] = v[i][2]; d[3] = v[i][3]; }
    asm volatile("s_waitcnt lgkmcnt(0)" ::: "memory");
    const int c = lane & 7;
#pragma unroll
    for (int j = 0; j < 4; ++j) { const int n = (lane >> 3) + 8 * j; const LAS float* s = scr + (8 * c) * 33 + n;
        u32x4 o; o.x = pk2(s[0 * 33], s[1 * 33]); o.y = pk2(s[2 * 33], s[3 * 33]); o.z = pk2(s[4 * 33], s[5 * 33]); o.w = pk2(s[6 * 33], s[7 * 33]);
        *(u32x4*)(WT + (size_t)(drow0 + n) * K + k0 + 8 * c) = o; }
    asm volatile("s_waitcnt lgkmcnt(0)" ::: "memory");
}

template <bool HAS_BR, bool WRITE_RES, bool WRITE_NORM, bool DO_IF>
__device__ __forceinline__ void rowpass(int gw, int ngw, int lane, const float* res, const bf16_t* br, float coef, const float* gbr, float* outres,
                                        const float* gn, bf16_t* outn, const LAS f32x4* wif, float* IF) {
    for (int row0 = gw; row0 < M; row0 += 2 * ngw) {
        f32x4 v[2][4]; u32x2 bw[2][4];
#pragma unroll
        for (int r = 0; r < 2; ++r) { const int row = (row0 + r * ngw < M) ? row0 + r * ngw : row0;
#pragma unroll
            for (int j = 0; j < 4; ++j) { v[r][j] = *((const f32x4*)(res + (size_t)row * DM) + lane + 64 * j);
                if constexpr (HAS_BR) bw[r][j] = *((const u32x2*)(br + (size_t)row * DM) + lane + 64 * j); } }
#pragma unroll
        for (int r = 0; r < 2; ++r) {
            const int row = row0 + r * ngw; if (row >= M) break;
            if constexpr (HAS_BR) {
                f32x4 b[4]; float ss = 0.f;
#pragma unroll
                for (int j = 0; j < 4; ++j) { const u32x2 w = bw[r][j];
                    b[j][0] = bf_lo(w.x); b[j][1] = bf_hi(w.x); b[j][2] = bf_lo(w.y); b[j][3] = bf_hi(w.y);
                    ss += (b[j][0] * b[j][0] + b[j][1] * b[j][1]) + (b[j][2] * b[j][2] + b[j][3] * b[j][3]); }
                const float rstd = coef * __builtin_amdgcn_rsqf(wave_sum(ss) * (1.0f / DM) + EPS);
#pragma unroll
                for (int j = 0; j < 4; ++j) { const f32x4 g = *((const f32x4*)gbr + lane + 64 * j); v[r][j] = v[r][j] + b[j] * g * rstd; }
            }
            if constexpr (WRITE_RES) {
#pragma unroll
                for (int j = 0; j < 4; ++j) *((f32x4*)(outres + (size_t)row * DM) + lane + 64 * j) = v[r][j];
            }
            if constexpr (WRITE_NORM) {
                float ss = 0.f;
#pragma unroll
                for (int j = 0; j < 4; ++j) ss += (v[r][j][0] * v[r][j][0] + v[r][j][1] * v[r][j][1]) + (v[r][j][2] * v[r][j][2] + v[r][j][3] * v[r][j][3]);
                const float rstd = __builtin_amdgcn_rsqf(wave_sum(ss) * (1.0f / DM) + EPS);
                f32x4 hn[4];
#pragma unroll
                for (int j = 0; j < 4; ++j) { const f32x4 g = *((const f32x4*)gn + lane + 64 * j); hn[j] = v[r][j] * g * rstd;
                    u32x2 w; w.x = pk2(hn[j][0], hn[j][1]); w.y = pk2(hn[j][2], hn[j][3]); *((u32x2*)(outn + (size_t)row * DM) + lane + 64 * j) = w; }
                if constexpr (DO_IF) {
                    f32x4 a0 = {0.f, 0.f, 0.f, 0.f}, a1 = {0.f, 0.f, 0.f, 0.f};
#pragma unroll
                    for (int j = 0; j < 4; ++j)
#pragma unroll
                        for (int e = 0; e < 4; ++e) { const f32x4 w0 = wif[((j * 4 + e) * 2 + 0) * 64 + lane], w1 = wif[((j * 4 + e) * 2 + 1) * 64 + lane];
                            a0 = a0 + w0 * hn[j][e]; a1 = a1 + w1 * hn[j][e]; }
                    float rr[8];
#pragma unroll
                    for (int c = 0; c < 4; ++c) { rr[c] = wave_sum(a0[c]); rr[4 + c] = wave_sum(a1[c]); }
                    if (lane == 0) { *(f32x4*)(IF + (size_t)row * 8) = (f32x4){rr[0], rr[1], rr[2], rr[3]}; *(f32x4*)(IF + (size_t)row * 8 + 4) = (f32x4){rr[4], rr[5], rr[6], rr[7]}; }
                }
            }
        }
    }
}

__device__ __forceinline__ void attn_item(LAS unsigned char* lds, bf16_t* Qb, const bf16_t* Kb, const bf16_t* Vb, float* LSE, int it, int tid, int wave, int lane) {
    const int g = it >> 9, rem = it & 511, b = rem >> 6, slot = (rem >> 4) & 3, x = rem & 15;
    int dil, r, blk;
    if (g == 0) { dil = 1; r = 0; blk = x; } else if (g == 1) { dil = 4; r = x >> 2; blk = x & 3; } else { dil = 16; r = x; blk = 0; }
    const int q0 = blk * 128, cb = g * 512 + slot * 128;
    const int fr = lane & 15, fq = lane >> 4;
    LAS unsigned char* KS = lds; LAS unsigned char* VS = lds + 65536;
    {
        u32x4 kv[8], vv[8];
#pragma unroll
        for (int i = 0; i < 8; ++i) {
            const int id = tid + 512 * i, row = id >> 4, ch = id & 15, kn = q0 - 128 + row, knc = kn < 0 ? 0 : kn;
            const size_t off = (size_t)(b * SEQ + knc * dil + r) * 1536 + cb + ch * 8; kv[i] = *(const u32x4*)(Kb + off); vv[i] = *(const u32x4*)(Vb + off);
        }
#pragma unroll
        for (int i = 0; i < 8; ++i) {
            const int id = tid + 512 * i, row = id >> 4, ch = id & 15, kn = q0 - 128 + row;
            const u32x4 z = {0u, 0u, 0u, 0u};
            *(LAS u32x4*)(KS + row * 256 + ((ch ^ (row & 15)) << 4)) = kn < 0 ? z : kv[i];
            *(LAS u32x4*)(VS + row * 256 + ((ch ^ ((row & 7) << 1)) << 4)) = kn < 0 ? z : vv[i];
        }
    }
    const int qn = q0 + 16 * wave + fr; const size_t qrow = (size_t)(b * SEQ + qn * dil + r);
    bf16x8 qf[4];
#pragma unroll
    for (int ks = 0; ks < 4; ++ks) qf[ks] = *(const bf16x8*)(Qb + qrow * 1536 + cb + 32 * ks + 8 * fq);
    __syncthreads();
    f32x4 sa[9];
#pragma unroll
    for (int j = 0; j < 9; ++j) {
        const int krow = 16 * (wave + j) + fr;
        f32x4 a = {0.f, 0.f, 0.f, 0.f};
#pragma unroll
        for (int ks = 0; ks < 4; ++ks) {
            const bf16x8 kf = *(const LAS bf16x8*)(KS + krow * 256 + (((4 * ks + fq) ^ (krow & 15)) << 4));
            a = MFMA16(kf, qf[ks], a);
        }
        sa[j] = a;
    }
    const int kmin = 128 - q0;
    float mx = -INFINITY;
#pragma unroll
    for (int j = 0; j < 9; ++j)
#pragma unroll
        for (int i = 0; i < 4; ++i) { const int rel = 16 * j + 4 * fq + i - fr, kidx = 16 * (wave + j) + 4 * fq + i;
            const bool ok = (rel >= 0) && (rel <= 128) && (kidx >= kmin);
            sa[j][i] = ok ? sa[j][i] : -INFINITY; mx = fmaxf(mx, sa[j][i]); }
    mx = fmaxf(mx, __shfl_xor(mx, 16)); mx = fmaxf(mx, __shfl_xor(mx, 32));
    float l = 0.f;
#pragma unroll
    for (int j = 0; j < 9; ++j)
#pragma unroll
        for (int i = 0; i < 4; ++i) { const float p = __builtin_amdgcn_exp2f(sa[j][i] - mx); sa[j][i] = p; l += p; }
    l += __shfl_xor(l, 16); l += __shfl_xor(l, 32);
    f32x4 oa[8];
#pragma unroll
    for (int dt = 0; dt < 8; ++dt) oa[dt] = (f32x4){0.f, 0.f, 0.f, 0.f};
    const int tq = fr >> 2, tp = fr & 3;
#pragma unroll
    for (int s2 = 0; s2 < 5; ++s2) {
        u32x4 pw;
        pw.x = pk2(sa[2 * s2][0], sa[2 * s2][1]); pw.y = pk2(sa[2 * s2][2], sa[2 * s2][3]);
        if (s2 < 4) { pw.z = pk2(sa[2 * s2 + 1][0], sa[2 * s2 + 1][1]); pw.w = pk2(sa[2 * s2 + 1][2], sa[2 * s2 + 1][3]); } else { pw.z = 0u; pw.w = 0u; }
        const bf16x8 pf = __builtin_bit_cast(bf16x8, pw);
        int ta = wave + 2 * s2, tb = wave + 2 * s2 + 1; if (tb > 15) tb = 15;
        const int ra = 16 * ta + 4 * fq + tq, rb = 16 * tb + 4 * fq + tq;
#pragma unroll
        for (int dt = 0; dt < 8; ++dt) {
            const int g8 = 4 * dt + tp;
            const s16x4 va = vtr(VS + ra * 256 + ((g8 ^ ((ra & 7) << 2)) << 3));
            const s16x4 vb = vtr(VS + rb * 256 + ((g8 ^ ((rb & 7) << 2)) << 3));
            oa[dt] = MFMA16(cat8(va, vb), pf, oa[dt]);
        }
    }
    const float inv = 1.0f / l;
#pragma unroll
    for (int dt = 0; dt < 8; ++dt) { u32x2 w; w.x = pk2(oa[dt][0] * inv, oa[dt][1] * inv); w.y = pk2(oa[dt][2] * inv, oa[dt][3] * inv);
        *(u32x2*)(Qb + qrow * 1536 + cb + 16 * dt + 4 * fq) = w; }
    if (fq == 0) LSE[qrow * 12 + g * 4 + slot] = (mx + __builtin_amdgcn_logf(l)) * 0.6931471805599453f;
    __syncthreads();
}

constexpr int ML_QS = 0, ML_KS = 33792, ML_CB = 67584, ML_VE = 92928, ML_AV = 99072, ML_WW = 105216, ML_NUM = 114432, ML_SC = 127744;
constexpr int ML_P = 528;
__device__ __forceinline__ float scan_sum(float v, int lane) {
#pragma unroll
    for (int o = 1; o < 64; o <<= 1) { const float t = __shfl_up(v, o); if (lane >= o) v += t; }
    return v;
}
__device__ __forceinline__ float scan_max(float v, int lane) {
#pragma unroll
    for (int o = 1; o < 64; o <<= 1) { const float t = __shfl_up(v, o); if (lane >= o) v = fmaxf(v, t); }
    return v;
}
struct ConvHalo { u32x4 h0, h1, h2; };
__device__ __forceinline__ void bf8_to_f(const u32x4 w, float* d) { d[0] = bf_lo(w.x); d[1] = bf_hi(w.x); d[2] = bf_lo(w.y); d[3] = bf_hi(w.y); d[4] = bf_lo(w.z); d[5] = bf_hi(w.z); d[6] = bf_lo(w.w); d[7] = bf_hi(w.w); }
__device__ __forceinline__ void conv_halo(const bf16_t* QKMV, int gid, ConvHalo& H) {
    const int cg = gid & 255, rest = gid >> 8, b = rest >> 6, t0 = (rest & 63) * 32;
    const bf16_t* base = QKMV + (size_t)(b * SEQ) * 3072 + cg * 8;
    H.h0 = (u32x4){0u, 0u, 0u, 0u}; H.h1 = H.h0; H.h2 = H.h0;
    if (t0 > 0) { H.h0 = *(const u32x4*)(base + (size_t)(t0 - 3) * 3072); H.h1 = *(const u32x4*)(base + (size_t)(t0 - 2) * 3072); H.h2 = *(const u32x4*)(base + (size_t)(t0 - 1) * 3072); }
}
__device__ __forceinline__ void conv_run(bf16_t* QKMV, const float* conv_w, const float* conv_b, int gid, const ConvHalo& H) {
    const int cg = gid & 255, rest = gid >> 8, b = rest >> 6, t0 = (rest & 63) * 32;
    bf16_t* base = QKMV + (size_t)(b * SEQ) * 3072 + cg * 8;
    float cw[4][8], cbv[8];
#pragma unroll
    for (int j = 0; j < 4; ++j) { const f32x4 a = *(const f32x4*)(conv_w + j * 2048 + cg * 8), c = *(const f32x4*)(conv_w + j * 2048 + cg * 8 + 4);
        cw[j][0] = a[0]; cw[j][1] = a[1]; cw[j][2] = a[2]; cw[j][3] = a[3]; cw[j][4] = c[0]; cw[j][5] = c[1]; cw[j][6] = c[2]; cw[j][7] = c[3]; }
    { const f32x4 a = *(const f32x4*)(conv_b + cg * 8), c = *(const f32x4*)(conv_b + cg * 8 + 4);
        cbv[0] = a[0]; cbv[1] = a[1]; cbv[2] = a[2]; cbv[3] = a[3]; cbv[4] = c[0]; cbv[5] = c[1]; cbv[6] = c[2]; cbv[7] = c[3]; }
    const float kscale = (cg < 128) ? 1.0f : 0.0625f;
    float x0[8], x1[8], x2[8];
    bf8_to_f(H.h0, x0); bf8_to_f(H.h1, x1); bf8_to_f(H.h2, x2);
    for (int tb = 0; tb < 32; tb += 8) {
        u32x4 raw[8];
#pragma unroll
        for (int r = 0; r < 8; ++r) raw[r] = *(const u32x4*)(base + (size_t)(t0 + tb + r) * 3072);
#pragma unroll
        for (int r = 0; r < 8; ++r) {
            float x3[8], o[8]; bf8_to_f(raw[r], x3);
#pragma unroll
            for (int e = 0; e < 8; ++e) { const float sv = cbv[e] + cw[0][e] * x0[e] + cw[1][e] * x1[e] + cw[2][e] * x2[e] + cw[3][e] * x3[e];
                o[e] = sv * __builtin_amdgcn_rcpf(1.0f + __expf(-sv)) * kscale; x0[e] = x1[e]; x1[e] = x2[e]; x2[e] = x3[e]; }
            u32x4 w; w.x = pk2(o[0], o[1]); w.y = pk2(o[2], o[3]); w.z = pk2(o[4], o[5]); w.w = pk2(o[6], o[7]);
            *(u32x4*)(base + (size_t)(t0 + tb + r) * 3072) = w;
        }
    }
}

__device__ __forceinline__ void gates_prepass(LAS unsigned char* lds, const float* IF, const float* i_bias, const float* f_bias, float* GT, int bh, int tid, int wave, int lane) {
    const int b = bh >> 2, h = bh & 3;
    LAS float* BT = (LAS float*)lds; LAS float* IB = BT + 2048; LAS float* CM = IB + 2048; LAS float* BL = CM + 2048; LAS float* GM = BL + 32; LAS float* MS = GM + 32;
    const float ib_h = i_bias[h], fb_h = f_bias[h];
    for (int c = wave; c < 32; c += 8) {
        const size_t row = (size_t)b * SEQ + 64 * c + lane;
        const float ipre = IF[row * 8 + h] + ib_h, fpre = IF[row * 8 + 4 + h] + fb_h;
        const float lf = fminf(fpre, 0.f) - log1pf(__expf(-fabsf(fpre)));
        const float bt = scan_sum(lf, lane), ib = ipre - bt, cm = scan_max(ib, lane), bl = __shfl(bt, 63), gm = wave_max(bl + ib);
        BT[64 * c + lane] = bt; IB[64 * c + lane] = ib; CM[64 * c + lane] = cm;
        if (lane == 0) { BL[c] = bl; GM[c] = gm; }
    }
    __syncthreads();
    if (tid == 0) { float m = 0.f; MS[0] = 0.f; for (int c = 0; c < 32; ++c) { m = fmaxf(BL[c] + m, GM[c]); MS[c + 1] = m; } }
    __syncthreads();
    for (int c = wave; c < 32; c += 8) {
        const float bt = BT[64 * c + lane], ib = IB[64 * c + lane], cm = CM[64 * c + lane], bl = BL[c], mc = MS[c], mn = MS[c + 1];
        const float mt = bt + fmaxf(mc, cm);
        float* g = GT + ((size_t)bh * 32 + c) * 384;
        g[lane] = ib; g[64 + lane] = bt - mt; g[128 + lane] = __expf(bt + mc - mt); g[192 + lane] = __expf(-mt); g[256 + lane] = __expf(bl + ib - mn); g[320 + lane] = __expf(bl + mc - mn);
    }
    __syncthreads();
}

__device__ __forceinline__ void mlstm_item(LAS unsigned char* lds, const bf16_t* QKMV, const float* GT, bf16_t* HPRE, float* SSQ, int it, int tid, int wave, int lane) {
    const int b = it >> 5, h = (it >> 3) & 3, sl = it & 7;
    const int fr = lane & 15, fq = lane >> 4, tq = fr >> 2, tp = fr & 3;
    LAS float* SC = (LAS float*)(lds + ML_SC);
    for (int i = tid; i < 25344 / 4; i += 512) ((LAS unsigned*)(lds + ML_CB))[i] = 0u;
    const int cch = (lane < 32 ? 0 : 1024) + h * 256 + (lane & 31) * 8;
    f32x4 cacc[2][3];
#pragma unroll
    for (int a = 0; a < 2; ++a)
#pragma unroll
        for (int v = 0; v < 3; ++v) cacc[a][v] = (f32x4){0.f, 0.f, 0.f, 0.f};
    const size_t rowb = (size_t)b * SEQ;
    const float* gt = GT + (size_t)(b * 4 + h) * 32 * 384;
    const int tg = wave;
    u32x4 xraw[8]; u32x4 vraw = {0u, 0u, 0u, 0u}; float gpre = 0.f;
#define ML_PREFETCH(c_) do { const int t0_ = 64 * (c_); \
        _Pragma("unroll") for (int rr = 0; rr < 8; ++rr) xraw[rr] = *(const u32x4*)(QKMV + (rowb + t0_ + 8 * tg + rr) * 3072 + cch); \
        if (wave < 4) vraw = *(const u32x4*)(QKMV + (rowb + t0_ + (tid >> 2)) * 3072 + 2048 + h * 256 + sl * 32 + (tid & 3) * 8); \
        if (tid < 384) gpre = gt[(c_) * 384 + tid]; } while (0)
    ML_PREFETCH(0);
    for (int c = 0; c < 32; ++c) {
        const int t0 = 64 * c;
        {
            LAS unsigned char* dst = lds + (lane < 32 ? ML_QS : ML_KS) + (lane & 31) * 16;
#pragma unroll
            for (int tt = 0; tt < 8; ++tt) *(LAS u32x4*)(dst + (8 * tg + tt) * ML_P) = xraw[tt];
        }
        if (wave < 4) { *(LAS u32x4*)(lds + ML_VE + (tid >> 2) * 96 + (tid & 3) * 16) = vraw; }
        else if (wave == 4) { *(LAS u32x4*)(lds + ML_VE + lane * 96 + 64) = (u32x4){0x3f80u, 0u, 0u, 0u}; *(LAS u32x4*)(lds + ML_VE + lane * 96 + 80) = (u32x4){0u, 0u, 0u, 0u}; }
        if (tid < 384) SC[tid] = gpre;
#if !defined(MLV) || !(MLV & 1)
        for (int i = tid; i < 64 * 52; i += 512) ((LAS float*)(lds + ML_NUM))[i] = 0.f;
#endif
        if (c + 1 < 32) ML_PREFETCH(c + 1);
        __syncthreads();
        if (wave < 4) {
            const int t = tid >> 2, c8 = tid & 3; const float at = SC[256 + t];
            const u32x4 w = *(const LAS u32x4*)(lds + ML_VE + t * 96 + c8 * 16);
            u32x4 o; o.x = pk2(bf_lo(w.x) * at, bf_hi(w.x) * at); o.y = pk2(bf_lo(w.y) * at, bf_hi(w.y) * at); o.z = pk2(bf_lo(w.z) * at, bf_hi(w.z) * at); o.w = pk2(bf_lo(w.w) * at, bf_hi(w.w) * at);
            *(LAS u32x4*)(lds + ML_AV + t * 96 + c8 * 16) = o;
        } else if (wave == 4) {
            *(LAS u32x4*)(lds + ML_AV + lane * 96 + 64) = (u32x4){f2bf(SC[256 + lane]), 0u, 0u, 0u}; *(LAS u32x4*)(lds + ML_AV + lane * 96 + 80) = (u32x4){0u, 0u, 0u, 0u};
        }
        {
            const int tt = wave >> 1;
#pragma unroll
            for (int u = 0; u < 2; ++u) {
                const int st = 2 * (wave & 1) + u;
                f32x4 a = {0.f, 0.f, 0.f, 0.f};
                if (st <= tt) {
#pragma unroll
                    for (int ks = 0; ks < 8; ++ks) {
                        const bf16x8 kf = *(const LAS bf16x8*)(lds + ML_KS + (16 * st + fr) * ML_P + 64 * ks + 16 * fq);
                        const bf16x8 qf = *(const LAS bf16x8*)(lds + ML_QS + (16 * tt + fr) * ML_P + 64 * ks + 16 * fq);
                        a = MFMA16(kf, qf, a);
                    }
                }
                const int t = 16 * tt + fr; const float bmt = SC[64 + t];
                float w[4];
#pragma unroll
                for (int i = 0; i < 4; ++i) { const int s2 = 16 * st + 4 * fq + i; w[i] = (s2 <= t) ? __expf(bmt + SC[s2]) * a[i] : 0.f; }
                u32x2 o; o.x = pk2(w[0], w[1]); o.y = pk2(w[2], w[3]);
                *(LAS u32x2*)(lds + ML_WW + t * 144 + (16 * st + 4 * fq) * 2) = o;
            }
        }
        __syncthreads();
#if defined(MLV) && (MLV & 1)
        for (int tile = wave; tile < 12; tile += 8) {
            const int tt = tile & 3, vt = tile >> 2;
            f32x4 aw = {0.f, 0.f, 0.f, 0.f}, ac = {0.f, 0.f, 0.f, 0.f};
#pragma unroll
            for (int k2 = 0; k2 < 2; ++k2) {
                const bf16x8 wf = *(const LAS bf16x8*)(lds + ML_WW + (16 * tt + fr) * 144 + 64 * k2 + 16 * fq);
                const LAS unsigned char* vp = lds + ML_VE + (32 * k2 + 8 * fq + tq) * 96 + (16 * vt + 4 * tp) * 2;
                aw = MFMA16(wf, cat8(vtr(vp), vtr(vp + 4 * 96)), aw);
            }
#pragma unroll
            for (int ks = 0; ks < 8; ++ks) {
                const bf16x8 qf = *(const LAS bf16x8*)(lds + ML_QS + (16 * tt + fr) * ML_P + 64 * ks + 16 * fq);
                const bf16x8 cf = *(const LAS bf16x8*)(lds + ML_CB + (16 * vt + fr) * ML_P + 64 * ks + 16 * fq);
                ac = MFMA16(qf, cf, ac);
            }
#pragma unroll
            for (int i = 0; i < 4; ++i) { const int t = 16 * tt + 4 * fq + i; ((LAS float*)(lds + ML_NUM))[t * 52 + 16 * vt + fr] = aw[i] + SC[128 + t] * ac[i]; }
        }
#else
        {
            const int tt = wave & 3, hf = wave >> 2;
            f32x4 aw[3], ac[3];
#pragma unroll
            for (int vt = 0; vt < 3; ++vt) { aw[vt] = (f32x4){0.f, 0.f, 0.f, 0.f}; ac[vt] = (f32x4){0.f, 0.f, 0.f, 0.f}; }
            {
                const bf16x8 wf = *(const LAS bf16x8*)(lds + ML_WW + (16 * tt + fr) * 144 + 64 * hf + 16 * fq);
#pragma unroll
                for (int vt = 0; vt < 3; ++vt) {
                    const LAS unsigned char* vp = lds + ML_VE + (32 * hf + 8 * fq + tq) * 96 + (16 * vt + 4 * tp) * 2;
                    aw[vt] = MFMA16(wf, cat8(vtr(vp), vtr(vp + 4 * 96)), aw[vt]);
                }
            }
#pragma unroll
            for (int k4 = 0; k4 < 4; ++k4) {
                const int ks = 4 * hf + k4;
                const bf16x8 qf = *(const LAS bf16x8*)(lds + ML_QS + (16 * tt + fr) * ML_P + 64 * ks + 16 * fq);
#pragma unroll
                for (int vt = 0; vt < 3; ++vt) {
                    const bf16x8 cf = *(const LAS bf16x8*)(lds + ML_CB + (16 * vt + fr) * ML_P + 64 * ks + 16 * fq);
                    ac[vt] = MFMA16(qf, cf, ac[vt]);
                }
            }
#pragma unroll
            for (int i = 0; i < 4; ++i) { const int t = 16 * tt + 4 * fq + i; const float in = SC[128 + t];
#pragma unroll
                for (int vt = 0; vt < 3; ++vt) atomicAdd((float*)((LAS float*)(lds + ML_NUM) + t * 52 + 16 * vt + fr), aw[vt][i] + in * ac[vt][i]); }
        }
#endif
        __syncthreads();
        {
            const int t = tid >> 3, v4 = (tid & 7) * 4;
            const LAS float* nr = (const LAS float*)(lds + ML_NUM) + t * 52;
            const float den = fmaxf(fabsf(nr[32]), SC[192 + t]); const float inv = 1.0f / den;
            const f32x4 nv = *(const LAS f32x4*)(nr + v4);
            const f32x4 hv = nv * inv;
            u32x2 o; o.x = pk2(hv[0], hv[1]); o.y = pk2(hv[2], hv[3]);
            *(u32x2*)(HPRE + (rowb + t0 + t) * 1024 + h * 256 + sl * 32 + v4) = o;
            float sq = (hv[0] * hv[0] + hv[1] * hv[1]) + (hv[2] * hv[2] + hv[3] * hv[3]);
            sq += __shfl_xor(sq, 1); sq += __shfl_xor(sq, 2); sq += __shfl_xor(sq, 4);
            if ((tid & 7) == 0) atomicAdd(SSQ + (rowb + t0 + t) * 4 + h, sq);
        }
        {
            const float decay = SC[320];
#pragma unroll
            for (int a = 0; a < 2; ++a) {
                const int kt = 2 * wave + a;
                bf16x8 kf[2];
#pragma unroll
                for (int k2 = 0; k2 < 2; ++k2) {
                    const LAS unsigned char* kp = lds + ML_KS + (32 * k2 + 8 * fq + tq) * ML_P + (16 * kt + 4 * tp) * 2;
                    kf[k2] = cat8(vtr(kp), vtr(kp + 4 * ML_P));
                }
#pragma unroll
                for (int vt = 0; vt < 3; ++vt) {
                    f32x4 acc = cacc[a][vt] * decay;
#pragma unroll
                    for (int k2 = 0; k2 < 2; ++k2) {
                        const LAS unsigned char* vp = lds + ML_AV + (32 * k2 + 8 * fq + tq) * 96 + (16 * vt + 4 * tp) * 2;
                        acc = MFMA16(kf[k2], cat8(vtr(vp), vtr(vp + 4 * 96)), acc);
                    }
                    cacc[a][vt] = acc;
                    u32x2 o; o.x = pk2(acc[0], acc[1]); o.y = pk2(acc[2], acc[3]);
                    *(LAS u32x2*)(lds + ML_CB + (16 * vt + fr) * ML_P + (16 * kt + 4 * fq) * 2) = o;
                }
            }
        }
        __syncthreads();
    }
#undef ML_PREFETCH
}

#define XB_TMO      128
#define XB_XCNT(j)  (256  + 64 * (j))
#define XB_XSUB(j)  (1280 + 64 * (j))
#define XB_XGEN(j)  (2304 + 64 * (j))
#define XB_TOP      3328
#define XB_TOPGEN   3392
#define XCD_BAR_WORDS 3456
#define XB_SPIN_CAP (1u << 18)

__device__ __forceinline__ unsigned xb_ld(unsigned* p)              { return __hip_atomic_load(p, __ATOMIC_RELAXED, __HIP_MEMORY_SCOPE_AGENT); }
__device__ __forceinline__ unsigned xb_add(unsigned* p, unsigned v) { return __hip_atomic_fetch_add(p, v, __ATOMIC_RELAXED, __HIP_MEMORY_SCOPE_AGENT); }
__device__ __forceinline__ unsigned xb_xcc_id() { return (unsigned)__builtin_amdgcn_s_getreg((3 << 11) | 20) & 0xFu; }
#define XB_SPIN(cond, bar) do { unsigned _sp = 0; while (cond) { __builtin_amdgcn_s_sleep(1); \
    if ((++_sp & 255u) == 0u) { if (xb_ld(&(bar)[XB_TMO])) break; if (_sp > XB_SPIN_CAP) { atomicAdd(&(bar)[XB_TMO], 1u); break; } } } } while (0)

struct XcdBarrier {
    unsigned* bar; unsigned x;
    volatile LAS unsigned* st;
};

__device__ __forceinline__ XcdBarrier xcd_barrier_post(unsigned* bar, volatile LAS unsigned* st) {
    XcdBarrier b; b.bar = bar; b.x = xb_xcc_id(); b.st = st;
    if (threadIdx.x == 0) (void)xb_add(&bar[XB_XCNT(b.x)], 1u);
    return b;
}
__device__ __forceinline__ void xcd_barrier_complete(unsigned* bar, unsigned x, unsigned& nloc, unsigned& nx) {
    const unsigned G = gridDim.x * gridDim.y * gridDim.z;
    unsigned sum, cnt, mine, sp = 0u;
    for (;;) {
        sum = 0u; cnt = 0u; mine = 0u;
#pragma unroll
        for (unsigned j = 0; j < 16; ++j) { const unsigned c = xb_ld(&bar[XB_XCNT(j)]); sum += c; cnt += (c > 0u) ? 1u : 0u; mine = (j == x) ? c : mine; }
        if (sum == G) break;
        __builtin_amdgcn_s_sleep(1);
        if ((++sp & 255u) == 0u) { if (xb_ld(&bar[XB_TMO])) break; if (sp > XB_SPIN_CAP) { atomicAdd(&bar[XB_TMO], 1u); break; } }
    }
    nloc = mine > 0u ? mine : 1u; nx = cnt > 0u ? cnt : 1u;
}

__device__ __forceinline__ void xcd_barrier(const XcdBarrier& b) {
    asm volatile("s_waitcnt vmcnt(0)" ::: "memory");
    __syncthreads();
    if (threadIdx.x == 0) {
        unsigned* bar = b.bar;
        __builtin_amdgcn_s_waitcnt(0);
        unsigned nloc = b.st[0], nx = b.st[1];
        if (nloc == 0u) { xcd_barrier_complete(bar, b.x, nloc, nx); b.st[0] = nloc; b.st[1] = nx; }
        const unsigned old = xb_add(&bar[XB_XSUB(b.x)], 1u);
        const unsigned gen = old / nloc;
        if (old + 1u == (gen + 1u) * nloc) {
            __builtin_amdgcn_fence(__ATOMIC_RELEASE, "agent");
            asm volatile("s_waitcnt vmcnt(0)" ::: "memory");
            const unsigned og = xb_add(&bar[XB_TOP], 1u);
            const unsigned tg = og / nx;
            if (og + 1u == (tg + 1u) * nx) xb_add(&bar[XB_TOPGEN], 1u);
            else XB_SPIN(xb_ld(&bar[XB_TOPGEN]) == tg, bar);
            __builtin_amdgcn_fence(__ATOMIC_ACQUIRE, "agent");
            xb_add(&bar[XB_XGEN(b.x)], 1u);
            asm volatile("s_waitcnt vmcnt(0)" ::: "memory");
        } else {
            XB_SPIN(xb_ld(&bar[XB_XGEN(b.x)]) == gen, bar);
            __builtin_amdgcn_fence(__ATOMIC_ACQUIRE, "agent");
            asm volatile("s_waitcnt vmcnt(0)" ::: "memory");
        }
    }
    __syncthreads();
}

#define grid_seam() xcd_barrier(bar)

constexpr int I_G = 16 * 88, I_D = 44 * 32, I_INA = 16 * 272, I_INB = 16 * 64, I_A = 8 * 32, I_M = 16 * 32;
constexpr int NIT = 6 * I_G + I_INA + I_INB + I_A + 2 * I_M;
__device__ __forceinline__ void conv_item(const Args& args, unsigned char* ws, int it, LAS float* scr, int lane) {
    bf16_t* WGU1 = (bf16_t*)(ws + WS_WGU1); bf16_t* WD1 = (bf16_t*)(ws + WS_WD1); bf16_t* WGU2 = (bf16_t*)(ws + WS_WGU2); bf16_t* WD2 = (bf16_t*)(ws + WS_WD2);
    bf16_t* WIN = (bf16_t*)(ws + WS_WIN); bf16_t* WA = (bf16_t*)(ws + WS_WA); bf16_t* WM = (bf16_t*)(ws + WS_WM); bf16_t* WO = (bf16_t*)(ws + WS_WO);
    int r = it;
    if (r < 4 * I_G) {
        const int w = r / I_G; r -= w * I_G; const int kb = r / 88, nb = r % 88;
        const float* src = args.in[w == 0 ? 2 : w == 1 ? 3 : w == 2 ? 18 : 19];
        tr_item(src, DFF, 32 * nb, 64 * kb, (w < 2) ? WGU1 : WGU2, 1024, 256 * (nb >> 2) + 32 * (nb & 3) + 128 * (w & 1), scr, lane); return; }
    r -= 4 * I_G;
    if (r < 2 * I_D) {
        const int w = r / I_D; r -= w * I_D; const int kb = r / 32, nb = r % 32;
        tr_item(args.in[w == 0 ? 4 : 20], 1024, 32 * nb, 64 * kb, w == 0 ? WD1 : WD2, DFF, 32 * nb, scr, lane); return; }
    r -= 2 * I_D;
    if (r < I_INA) { const int kb = r / 272, nb = r % 272; tr_item(args.in[7], INW, 32 * nb, 64 * kb, WIN, 1024, 32 * nb, scr, lane); return; }
    r -= I_INA;
    if (r < I_INB) { const int kb = r / 64, nb = r % 64; tr_item(args.in[7], INW, 8712 + 32 * nb, 64 * kb, WIN, 1024, 8704 + 32 * nb, scr, lane); return; }
    r -= I_INB;
    if (r < I_A) { const int kb = r / 32, nb = r % 32; tr_item(args.in[13], 1024, 32 * nb, 64 * kb, WA, 512, 32 * nb, scr, lane); return; }
    r -= I_A;
    if (r < I_M) { const int kb = r / 32, nb = r % 32; tr_item(args.in[14], 1024, 32 * nb, 64 * kb, WM, 1024, 32 * nb, scr, lane); return; }
    r -= I_M;
    { const int kb = r / 32, nb = r % 32; tr_item(args.in[15], 1024, 32 * nb, 64 * kb, WO, 1024, 32 * nb, scr, lane); }
}
template <int GRP> __device__ __forceinline__ void conv_group(const Args& args, unsigned char* ws, int w, int nw, LAS float* scr, int lane) {
    constexpr int NV = GRP == 0 ? 2 * I_G : GRP == 1 ? I_D + I_INA + I_INB : 2 * I_G + I_D + I_A + 2 * I_M;
    for (int v = w; v < NV; v += nw) {
        int it;
        if (GRP == 0) it = v;
        else if (GRP == 1) it = v < I_D ? 4 * I_G + v : 4 * I_G + 2 * I_D + (v - I_D);
        else it = v < 2 * I_G ? 2 * I_G + v : v < 2 * I_G + I_D ? 4 * I_G + I_D + (v - 2 * I_G) : 4 * I_G + 2 * I_D + I_INA + I_INB + (v - 2 * I_G - I_D);
        conv_item(args, ws, it, scr, lane);
    }
}

__global__ void __launch_bounds__(512, 2) hybrid_fwd(Args args) {
    extern __shared__ __attribute__((aligned(16))) unsigned char lds_raw[];
    LAS unsigned char* lds = (LAS unsigned char*)lds_raw;

    const int tid = threadIdx.x, lane = tid & 63, wave = __builtin_amdgcn_readfirstlane(tid >> 6);
    const int G = gridDim.x, bid = blockIdx.x;
    const int gw = bid * 8 + wave, ngw = G * 8;
    unsigned char* ws = args.ws;
    if (tid < 2) ((LAS unsigned*)(lds + RING_BYTES))[tid] = 0u;
    __syncthreads();
    cg::this_grid().sync();
    XcdBarrier bar = xcd_barrier_post((unsigned*)ws, (volatile LAS unsigned*)(lds + RING_BYTES));
    const float* x = args.in[0];
    float* X = args.out;
    bf16_t* WGU1 = (bf16_t*)(ws + WS_WGU1); bf16_t* WD1 = (bf16_t*)(ws + WS_WD1); bf16_t* WGU2 = (bf16_t*)(ws + WS_WGU2); bf16_t* WD2 = (bf16_t*)(ws + WS_WD2);
    bf16_t* WIN = (bf16_t*)(ws + WS_WIN); bf16_t* WA = (bf16_t*)(ws + WS_WA); bf16_t* WM = (bf16_t*)(ws + WS_WM); bf16_t* WO = (bf16_t*)(ws + WS_WO);
    bf16_t* H = (bf16_t*)(ws + WS_H); bf16_t* ACT = (bf16_t*)(ws + WS_ACT); bf16_t* F = (bf16_t*)(ws + WS_F);
    bf16_t* Qb = (bf16_t*)(ws + WS_Q); bf16_t* ATT = (bf16_t*)(ws + WS_ATT); bf16_t* QKMV = (bf16_t*)(ws + WS_QKMV); bf16_t* HPRE = (bf16_t*)(ws + WS_HPRE);
    bf16_t* OG = (bf16_t*)(ws + WS_OG); bf16_t* Y = (bf16_t*)(ws + WS_Y);
    float* IF = (float*)(ws + WS_IF); float* LSE = (float*)(ws + WS_LSE); float* ROPE = (float*)(ws + WS_ROPE); float* GT = (float*)(ws + WS_GT); float* SSQ = (float*)(ws + WS_SSQ);

    {
        LAS float* scr = (LAS float*)(lds + wave * 16384);
        conv_group<0>(args, ws, gw, ngw, scr, lane);
        for (int i = bid * 512 + tid; i < M * 4; i += G * 512) SSQ[i] = 0.f;
        rowpass<false, false, true, false>(gw, ngw, lane, x, nullptr, 0.f, nullptr, nullptr, args.in[1], H, nullptr, nullptr);
    }
    grid_seam();
    { pg8::Gemm g{H, WGU1, M, 5632, 1024}; pg8::StaticOrder S; S.init(M, 5632, G, bid); pg8::Epi<1> E{ACT, DFF, nullptr, 0, 0, nullptr, 1.f, 0};
      pg8::gemm_phase<pg8::Epi<1>, pg8::StaticOrder, true, true>(lds, g, S, E); }
    if (bid >= 128) conv_group<1>(args, ws, (bid - 128) * 8 + wave, (G - 128) * 8, (LAS float*)(lds + wave * 16384), lane);
    grid_seam();
    { pg8::Gemm g{ACT, WD1, M, 1024, DFF}; pg8::StaticOrder S; S.init(M, 1024, G, bid); pg8::Epi<0> E{F, 1024, nullptr, 0, 0, nullptr, 1.f, 0};
      pg8::gemm_phase<pg8::Epi<0>, pg8::StaticOrder, true, true>(lds, g, S, E); }
    grid_seam();
    {
        LAS f32x4* wif = (LAS f32x4*)lds;
        const float* win = args.in[7];
        for (int i = tid; i < 32 * 64; i += 512) { const int ln = i & 63, q = i >> 6, half = q & 1, e = (q >> 1) & 3, j = q >> 3; const int k = 4 * ln + e + 256 * j;
            const float* p = win + (size_t)k * INW + 8704 + 4 * half; wif[i] = (f32x4){p[0], p[1], p[2], p[3]}; }
        __syncthreads();
        rowpass<true, true, true, true>(gw, ngw, lane, x, F, 0.5f, args.in[5], X, args.in[6], H, wif, IF);
        __syncthreads();
    }
    grid_seam();
    { pg8::Gemm g{H, WIN, M, 4608, 1024}; pg8::StaticOrder S; S.init(M, 4608, G, bid);
      pg8::Epi<3> E{Qb, 1536, nullptr, 0, 0, nullptr, 0.08838834764831845f * 1.4426950408889634f, (size_t)M * 1536};
      pg8::gemm_phase<pg8::Epi<3>, pg8::StaticOrder, true, true>(lds, g, S, E); }
    if (bid >= G - 32) gates_prepass(lds, IF, args.in[10], args.in[11], GT, bid - (G - 32), tid, wave, lane);
    else if (bid >= 128) conv_group<2>(args, ws, (bid - 128) * 8 + wave, (G - 32 - 128) * 8, (LAS float*)(lds + wave * 16384), lane);
    grid_seam();
    for (int it = bid; it < 1536; it += G) attn_item(lds, Qb, Qb + (size_t)M * 1536, Qb + (size_t)2 * M * 1536, LSE, it, tid, wave, lane);
    grid_seam();
    for (int row = gw; row < M; row += ngw) {
        const int slot = lane >> 4;
        const float l0 = LSE[(size_t)row * 12 + slot], l1 = LSE[(size_t)row * 12 + 4 + slot], l2 = LSE[(size_t)row * 12 + 8 + slot];
        const float mx = fmaxf(l0, fmaxf(l1, l2));
        float e0 = __expf(l0 - mx), e1 = __expf(l1 - mx), e2 = __expf(l2 - mx); const float inv = 1.0f / (e0 + e1 + e2); e0 *= inv; e1 *= inv; e2 *= inv;
        f32x4 a0, a1, b0, b1, c0, c1;
        pg8::load8(Qb + (size_t)row * 1536 + 8 * lane, a0, a1); pg8::load8(Qb + (size_t)row * 1536 + 512 + 8 * lane, b0, b1); pg8::load8(Qb + (size_t)row * 1536 + 1024 + 8 * lane, c0, c1);
        pg8::store8(ATT + (size_t)row * 512 + 8 * lane, a0 * e0 + b0 * e1 + c0 * e2, a1 * e0 + b1 * e1 + c1 * e2);
    }
    { pg8::Gemm g{H, WIN + (size_t)4608 * 1024, M, 3072, 1024}; pg8::StaticOrder S; S.init(M, 3072, G, bid); pg8::Epi<0> E{QKMV, 3072, nullptr, 0, 0, nullptr, 1.f, 0};
      pg8::gemm_phase<pg8::Epi<0>, pg8::StaticOrder, true, true>(lds, g, S, E); }
    grid_seam();
    { ConvHalo CH; conv_halo(QKMV, bid * 512 + tid, CH); grid_seam(); conv_run(QKMV, args.in[8], args.in[9], bid * 512 + tid, CH); }
    grid_seam();
    for (int it = bid; it < 256; it += G) mlstm_item(lds, QKMV, GT, HPRE, SSQ, it, tid, wave, lane);
    grid_seam();
    { pg8::Gemm g{H, WIN + (size_t)7680 * 1024, M, 3072, 1024}; pg8::StaticOrder S; S.init(M, 3072, G, bid); pg8::Epi<6> E{OG, 3072, nullptr, 0, 0, nullptr, 1.f, 0, HPRE, SSQ, args.in[12]};
      pg8::gemm_phase<pg8::Epi<6>, pg8::StaticOrder, true, true>(lds, g, S, E); }
    grid_seam();
    { pg8::Gemm g{ATT, WA, M, 1024, 512}; pg8::StaticOrder S; S.init(M, 1024, G, bid); pg8::Epi<4> E{H, 1024, OG, 3072, 1024, nullptr, 1.f, 0};
      pg8::gemm_phase<pg8::Epi<4>, pg8::StaticOrder, true, true>(lds, g, S, E); }
    { pg8::Gemm g{HPRE, WM, M, 1024, 1024}; pg8::StaticOrder S; S.init(M, 1024, G, bid); pg8::Epi<5> E{H, 1024, OG, 3072, 2048, nullptr, 1.f, 0};
      pg8::gemm_phase<pg8::Epi<5>, pg8::StaticOrder, true, true>(lds, g, S, E); }
    grid_seam();
    { pg8::Gemm g{H, WO, M, 1024, 1024}; pg8::StaticOrder S; S.init(M, 1024, G, bid); pg8::Epi<0> E{Y, 1024, nullptr, 0, 0, nullptr, 1.f, 0};
      pg8::gemm_phase<pg8::Epi<0>, pg8::StaticOrder, true, true>(lds, g, S, E); }
    grid_seam();
    rowpass<true, true, true, false>(gw, ngw, lane, X, Y, 1.0f, args.in[16], X, args.in[17], H, nullptr, nullptr);
    grid_seam();
    { pg8::Gemm g{H, WGU2, M, 5632, 1024}; pg8::StaticOrder S; S.init(M, 5632, G, bid); pg8::Epi<1> E{ACT, DFF, nullptr, 0, 0, nullptr, 1.f, 0};
      pg8::gemm_phase<pg8::Epi<1>, pg8::StaticOrder, true, true>(lds, g, S, E); }
    grid_seam();
    { pg8::Gemm g{ACT, WD2, M, 1024, DFF}; pg8::StaticOrder S; S.init(M, 1024, G, bid); pg8::Epi<0> E{F, 1024, nullptr, 0, 0, nullptr, 1.f, 0};
      pg8::gemm_phase<pg8::Epi<0>, pg8::StaticOrder, true, true>(lds, g, S, E); }
    grid_seam();
    rowpass<true, true, false, false>(gw, ngw, lane, X, F, 0.5f, args.in[21], X, nullptr, nullptr, nullptr, nullptr);
}

extern "C" void kernel_launch(void* const* d_in, const int* in_sizes, int n_in, void* d_out, int out_size, void* d_ws, size_t ws_size, hipStream_t stream) {
    static int grid = 0;
    if (grid == 0) {
        if (n_in != 22 || out_size != M * DM || ws_size < WS_END) { fprintf(stderr, "kernel_launch: unexpected shapes (n_in %d out %d ws %zu)\n", n_in, out_size, ws_size); grid = -1; return; }
        int dev = 0, cus = 0, per_cu = 0;
        hipGetDevice(&dev);
        hipDeviceGetAttribute(&cus, hipDeviceAttributeMultiprocessorCount, dev);
        if (hipFuncSetAttribute((const void*)hybrid_fwd, hipFuncAttributeMaxDynamicSharedMemorySize, LDS_BYTES) != hipSuccess) { fprintf(stderr, "kernel_launch: hipFuncSetAttribute failed\n"); grid = -1; return; }
        if (hipOccupancyMaxActiveBlocksPerMultiprocessor(&per_cu, (const void*)hybrid_fwd, 512, LDS_BYTES) != hipSuccess || per_cu < 1) { fprintf(stderr, "kernel_launch: occupancy query says %d\n", per_cu); per_cu = 1; }
        (void)hipGetLastError();
        grid = cus;
        if (grid > 256) grid = 256;
    }
    if (grid < 0) return;
    Args a{};
    for (int i = 0; i < 22; ++i) a.in[i] = (const float*)d_in[i];
    a.out = (float*)d_out; a.ws = (unsigned char*)d_ws;
    if (hipMemsetAsync(d_ws, 0, 16384, stream) != hipSuccess) { fprintf(stderr, "memset failed\n"); return; }
    void* kargs[] = {&a};
    hipError_t e = hipLaunchCooperativeKernel((const void*)hybrid_fwd, dim3(grid), dim3(512), kargs, LDS_BYTES, stream);
    if (e != hipSuccess) fprintf(stderr, "cooperative launch failed: %s (grid %d)\n", hipGetErrorString(e), grid);
}
```
